# Optimizing an MI355X kernel written in HIP

```python
import jax, jax.numpy as jnp
from jax import lax
import numpy as np

D_MODEL = 2048
BATCH = 8
SEQ = 4096
DEPTH = 2
DEC_BATCH = 2
DEC_SEQ = 4096
PAST_LEN = 128

HA = 8
HKV = 2
GROUP = HA // HKV
DH = 128
WA = HA * DH
WKV = HKV * DH
WINDOW = 128
BLOCK = 128
N_BUCKETS = 32
MAX_DIST = 128
HB = 4
DK = 128
DV = 256
WBK = HB * DK
WB = HB * DV
GATE_RANK = 16
GATE_NORM = 16.0
CHUNK = 64
SPLITS = [WA, WKV, WKV, WA, WBK, WBK, WB, WB, GATE_RANK, GATE_RANK]
D_IN = sum(SPLITS)
D_MIX = WA + WB
NEG = -1e30

kernel_name = "hymba_style_bidir_swa_gla_encoder"


def rms_norm(x, w, eps=1e-6):
    xf = x.astype(jnp.float32)
    y = xf * lax.rsqrt(jnp.mean(xf * xf, axis=-1, keepdims=True) + eps)
    return (y * w.astype(jnp.float32)).astype(x.dtype)


def _band_static():
    qi = np.arange(BLOCK)[:, None]
    kj = np.arange(3 * BLOCK)[None, :]
    rel = kj - BLOCK - qi
    nb = N_BUCKETS // 2
    max_exact = nb // 2
    n = np.abs(rel)
    large = max_exact + (np.log(np.maximum(n, 1) / max_exact) / np.log(MAX_DIST / max_exact)
                         * (nb - max_exact)).astype(np.int32)
    large = np.minimum(large, nb - 1)
    bucket = (rel > 0).astype(np.int32) * nb + np.where(n < max_exact, n, large)
    return bucket.astype(np.int32), (n <= WINDOW)


def windowed_gqa(q, k, v, rel_bias, sink):
    B, L = q.shape[0], q.shape[1]
    nb = L // BLOCK
    bucket, in_band = _band_static()
    pos_bias = jnp.transpose(rel_bias[bucket], (2, 0, 1)).astype(jnp.float32)
    pad = ((0, 0), (BLOCK, BLOCK), (0, 0), (0, 0))
    kp = jnp.pad(k, pad).reshape(B, nb + 2, BLOCK, HKV, DH)
    vp = jnp.pad(v, pad).reshape(B, nb + 2, BLOCK, HKV, DH)
    kw = jnp.concatenate([kp[:, :-2], kp[:, 1:-1], kp[:, 2:]], axis=2)
    vw = jnp.concatenate([vp[:, :-2], vp[:, 1:-1], vp[:, 2:]], axis=2)
    qb = q.reshape(B, nb, BLOCK, HKV, GROUP, DH)
    s = jnp.einsum('bnqhgd,bnkhd->bnhgqk', qb, kw).astype(jnp.float32) * (DH ** -0.5)
    s = s.reshape(B, nb, HA, BLOCK, 3 * BLOCK) + pos_bias
    key_pos = np.arange(nb)[:, None] * BLOCK + np.arange(3 * BLOCK)[None, :] - BLOCK
    valid = in_band[None] & ((key_pos >= 0) & (key_pos < L))[:, None, :]
    s = jnp.where(valid[None, :, None], s, NEG)
    sink_f = sink.astype(jnp.float32)[None, None, :, None, None]
    m = jnp.maximum(jnp.max(s, axis=-1, keepdims=True), sink_f)
    p = jnp.exp(s - m)
    p = p / (jnp.sum(p, axis=-1, keepdims=True) + jnp.exp(sink_f - m))
    p = p.astype(v.dtype).reshape(B, nb, HKV, GROUP, BLOCK, 3 * BLOCK)
    o = jnp.einsum('bnhgqk,bnkhd->bnqhgd', p, vw)
    return o.reshape(B, L, WA)


def gla_direction(q, k, v, g):
    B, L = q.shape[0], q.shape[1]
    nc = L // CHUNK
    q = q.reshape(B, nc, CHUNK, HB, DK)
    k = k.reshape(B, nc, CHUNK, HB, DK)
    v = v.reshape(B, nc, CHUNK, HB, DV)
    b = jnp.cumsum(g.reshape(B, nc, CHUNK, HB, DK), axis=2)
    b_last = b[:, :, -1:]
    q_dec = q * jnp.exp(b)
    k_dec = k * jnp.exp(-b)
    k_tail = k * jnp.exp(b_last - b)
    tri = np.tril(np.ones((CHUNK, CHUNK), dtype=bool))
    a = jnp.where(tri, jnp.einsum('bnihd,bnjhd->bnhij', q_dec, k_dec), 0.0)
    o_intra = jnp.einsum('bnhij,bnjhv->bnihv', a, v)
    kv = jnp.einsum('bnjhd,bnjhv->bnhdv', k_tail, v)
    decay = jnp.exp(b_last[:, :, 0])

    def step(S, inp):
        qd, dec, kvc = inp
        o = jnp.einsum('bihd,bhdv->bihv', qd, S)
        return S * dec[..., None] + kvc, o

    S0 = jnp.zeros((B, HB, DK, DV), jnp.float32)
    _, o_inter = lax.scan(step, S0, (jnp.moveaxis(q_dec, 1, 0), jnp.moveaxis(decay, 1, 0),
                                     jnp.moveaxis(kv, 1, 0)))
    o = o_intra + jnp.moveaxis(o_inter, 0, 1)
    return o.reshape(B, L, HB, DV)


def hybrid_layer(x, rel_bias, w_in, w_gk_f, b_gk_f, w_gk_b, b_gk_b, sink, gla_norm, w_out,
                 norm_pre, norm_post):
    B, L = x.shape[0], x.shape[1]
    h = rms_norm(x, norm_pre)
    proj = h @ w_in
    qa, ka, va, za, qb, kb, vb, zb, lrf, lrb = jnp.split(proj, list(np.cumsum(SPLITS)[:-1]), axis=-1)
    attn = windowed_gqa(qa.reshape(B, L, HA, DH), ka.reshape(B, L, HKV, DH),
                        va.reshape(B, L, HKV, DH), rel_bias, sink)
    attn = attn * jax.nn.silu(za)
    f32 = jnp.float32
    q_b = qb.astype(f32).reshape(B, L, HB, DK) * (DK ** -0.5)
    k_b = kb.astype(f32).reshape(B, L, HB, DK)
    v_b = vb.astype(f32).reshape(B, L, HB, DV)
    g_f = (jax.nn.log_sigmoid((lrf @ w_gk_f + b_gk_f).astype(f32)) / GATE_NORM).reshape(B, L, HB, DK)
    g_b = (jax.nn.log_sigmoid((lrb @ w_gk_b + b_gk_b).astype(f32)) / GATE_NORM).reshape(B, L, HB, DK)
    o_fwd = gla_direction(q_b, k_b, v_b, g_f)
    o_bwd = jnp.flip(gla_direction(jnp.flip(q_b, 1), jnp.flip(k_b, 1), jnp.flip(v_b, 1),
                                   jnp.flip(g_b, 1)), 1)
    o_gla = rms_norm((o_fwd + o_bwd).astype(x.dtype), gla_norm)
    o_gla = o_gla.reshape(B, L, WB) * jax.nn.silu(zb)
    mix = jnp.concatenate([attn, o_gla], axis=-1) @ w_out
    return x + rms_norm(mix, norm_post)


def setup_inputs(seed: int = 0) -> dict:
    key = jax.random.key(seed)
    ks = jax.random.split(key, 16)
    nrm = jax.random.normal
    return {
        "x_prompt": nrm(ks[0], (BATCH, SEQ, D_MODEL), jnp.float32),
        "x_sample": nrm(ks[1], (DEC_BATCH, DEC_SEQ, D_MODEL), jnp.float32),
        "rel_bias": 0.5 * nrm(ks[2], (N_BUCKETS, HA), jnp.float32),
        "w_in": nrm(ks[3], (DEPTH, D_MODEL, D_IN), jnp.float32) * D_MODEL ** -0.5,
        "w_gk_fwd": nrm(ks[4], (DEPTH, GATE_RANK, WBK), jnp.float32) * GATE_RANK ** -0.5,
        "b_gk_fwd": 0.1 * nrm(ks[5], (DEPTH, WBK), jnp.float32),
        "w_gk_bwd": nrm(ks[6], (DEPTH, GATE_RANK, WBK), jnp.float32) * GATE_RANK ** -0.5,
        "b_gk_bwd": 0.1 * nrm(ks[7], (DEPTH, WBK), jnp.float32),
        "sink": 0.5 * nrm(ks[8], (DEPTH, HA), jnp.float32),
        "gla_norm": 1.0 + 0.02 * nrm(ks[9], (DEPTH, DV), jnp.float32),
        "w_out": nrm(ks[10], (DEPTH, D_MIX, D_MODEL), jnp.float32) * D_MIX ** -0.5,
        "norm_pre": 1.0 + 0.02 * nrm(ks[11], (DEPTH, D_MODEL), jnp.float32),
        "norm_post": 1.0 + 0.02 * nrm(ks[12], (DEPTH, D_MODEL), jnp.float32),
    }


def reference(x_prompt, x_sample, rel_bias, w_in, w_gk_fwd, b_gk_fwd, w_gk_bwd, b_gk_bwd, sink,
              gla_norm, w_out, norm_pre, norm_post):
    y_prompt = x_prompt
    y_sample = x_sample
    for l in range(DEPTH):
        y_prompt = hybrid_layer(y_prompt, rel_bias, w_in[l], w_gk_fwd[l], b_gk_fwd[l], w_gk_bwd[l],
                                b_gk_bwd[l], sink[l], gla_norm[l], w_out[l], norm_pre[l], norm_post[l])
        y_sample = hybrid_layer(y_sample, rel_bias, w_in[l], w_gk_fwd[l], b_gk_fwd[l], w_gk_bwd[l],
                                b_gk_bwd[l], sink[l], gla_norm[l], w_out[l], norm_pre[l], norm_post[l])
    return (y_prompt, y_sample)
```

```cpp
#include <hip/hip_runtime.h>
#include <hip/hip_cooperative_groups.h>
#include <cstdio>
#include <cstdint>
namespace cg = cooperative_groups;

#ifndef MK_ONE_LAUNCH
#define MK_ONE_LAUNCH 1
#endif

constexpr int MTOK = 40960, DM = 2048, SEQL = 4096, NSEQ = 10, NPROMPT = 32768;
constexpr int NIN = 5664, NMAIN = 5632;
constexpr int NTHR = 512;
constexpr float LOG2E = 1.4426950408889634f;
constexpr float QSCALE_A = 0.08838834764831845f * 1.4426950408889634f;
constexpr float QSCALE_B = 0.08838834764831845f;
constexpr float EPS = 1e-6f;
constexpr int LDS_BYTES = 155904;
constexpr int LDS_BARW = 155648;

constexpr size_t WS_WIN  = 0;
constexpr size_t WS_WOUT = WS_WIN + (size_t)2 * NIN * DM * 2;
constexpr size_t WS_PA   = WS_WOUT + (size_t)2 * DM * DM * 2;
constexpr size_t WS_PG   = WS_PA + (size_t)MTOK * 2560 * 2;
constexpr size_t WS_PZ   = WS_PG + (size_t)MTOK * 2048 * 2;
constexpr size_t WS_LR   = WS_PZ + (size_t)MTOK * 1024 * 2;
constexpr size_t WS_XB   = WS_LR + (size_t)MTOK * 32 * 4;
constexpr size_t WS_SSQ  = WS_XB + (size_t)MTOK * DM * 2;
constexpr size_t WS_RSTD = WS_SSQ + (size_t)MTOK * 32 * 4;
constexpr size_t WS_TAB  = WS_RSTD + (size_t)MTOK * 4;
constexpr size_t WS_CTL  = WS_TAB + 16384;
constexpr size_t WS_GLA  = WS_CTL + 16384;
constexpr size_t WS_MIXOUT = WS_PG;
constexpr size_t GL_PD_BYTES = 40960;
constexpr size_t GL_PD  = WS_GLA;
constexpr size_t GL_VT  = GL_PD + (size_t)2 * 2560 * GL_PD_BYTES;
constexpr size_t GL_DEC = GL_VT + (size_t)2560 * 32768;
constexpr size_t GL_END = GL_DEC + (size_t)2 * 2560 * 512;
constexpr size_t WS_OFB = WS_PG;
constexpr size_t WS_KB = GL_END;
constexpr size_t WS_VB = WS_KB + (size_t)2 * MTOK * 128 * 2;
constexpr size_t WS_SSQ0 = WS_VB + (size_t)2 * MTOK * 128 * 2;
constexpr size_t WS_END = WS_SSQ0 + (size_t)MTOK * 32 * 4;

typedef unsigned short bf16_t;
typedef short bf16x8 __attribute__((ext_vector_type(8)));
typedef short s16x4 __attribute__((ext_vector_type(4)));
typedef float f32x4 __attribute__((ext_vector_type(4)));
typedef float f32x16 __attribute__((ext_vector_type(16)));
typedef unsigned u32x4 __attribute__((ext_vector_type(4)));
typedef unsigned u32x2 __attribute__((ext_vector_type(2)));
#define LAS __attribute__((address_space(3)))
#define DI __device__ __forceinline__

DI unsigned cvt_pk_bf16(float lo, float hi) { unsigned r; asm volatile("v_cvt_pk_bf16_f32 %0, %1, %2" : "=v"(r) : "v"(lo), "v"(hi)); return r; }
DI float bf2f(bf16_t b) { return __uint_as_float(((unsigned)b) << 16); }
DI float bflo(unsigned w) { return __uint_as_float(w << 16); }
DI float bfhi(unsigned w) { return __uint_as_float(w & 0xffff0000u); }
DI bf16_t f2bf(float f) { return (bf16_t)(cvt_pk_bf16(f, 0.f) & 0xffffu); }
DI float wave_sum(float v) { for (int o = 32; o >= 1; o >>= 1) v += __shfl_xor(v, o); return v; }
DI float silu(float z) { return z / (1.0f + __expf(-z)); }
DI float logsigmoid(float z) { return fminf(z, 0.f) - log1pf(__expf(-fabsf(z))); }

struct Params {
    const float* x_prompt; const float* x_sample; const float* rel_bias; const float* w_in; const float* w_gk_f; const float* b_gk_f;
    const float* w_gk_b; const float* b_gk_b; const float* sink; const float* gla_norm; const float* w_out; const float* norm_pre; const float* norm_post;
    float* out; unsigned char* ws; int ph_lo, ph_hi;
};

namespace pg8 {
#define PG8_LAS __attribute__((address_space(3)))
typedef unsigned short bf16_t;
typedef short bf16x8 __attribute__((ext_vector_type(8)));
typedef float f32x4 __attribute__((ext_vector_type(4)));
typedef unsigned u32x4 __attribute__((ext_vector_type(4)));
constexpr int BM = 256, BK = 64, HALF = 128, HTB = HALF * BK * 2  , STAGE_BYTES = 8 * HTB, NXCD = 8, WGM = 4;

__host__ __device__ __forceinline__ int lds_byte(int r, int c) { const int st = (r >> 4) * 2 + (c >> 5), rr = r & 15, cc = c & 31, ob = rr * 64 + cc * 2; return st * 1024 + (ob ^ (((ob >> 9) & 1) << 5)); }
__host__ __device__ __forceinline__ void stage_rc(int b, int& R, int& C) { const int st = b / 1024, sb = b % 1024, swz = sb ^ (((sb >> 9) & 1) << 5); R = (st >> 1) * 16 + swz / 64; C = (st & 1) * 32 + (swz % 64) / 2; }
__host__ __device__ __forceinline__ int perm32(int rho) { const int n = rho >> 4, i = rho & 15; return 8 * (i >> 2) + 4 * n + (i & 3); }

struct Unit { int pm, pn; };
struct Gemm { const bf16_t* A; const bf16_t* Bt; int M, N, K; };

struct StaticOrder {
    int nM, nN, nwg, G, c;
    __host__ __device__ void init(int M, int N, int G_, int c_) { nM = M / BM; nN = N / BM; nwg = nM * nN; G = G_; c = c_; }
    __host__ __device__ bool next(int i, Unit& u) const {
        const long L = (long)i * G + c; if (L >= nwg) return false;
        int wgid = (int)L; { const int q = nwg / NXCD, r = nwg % NXCD, xcd = wgid % NXCD, off = wgid / NXCD; wgid = (xcd < r ? xcd * (q + 1) : r * (q + 1) + (xcd - r) * q) + off; }
        const int nig = WGM * nN, gid = wgid / nig, fm = gid * WGM, gsz = (nM - fm) < WGM ? (nM - fm) : WGM;
        u.pm = fm + ((wgid % nig) % gsz); u.pn = (wgid % nig) / gsz; return true;
    }
    __device__ __forceinline__ void a_ready(const Unit&) const {}
    __device__ __forceinline__ void done(const Unit&) const {}
};


__device__ __forceinline__ unsigned cvt_pk(float lo, float hi) { unsigned r; asm volatile("v_cvt_pk_bf16_f32 %0, %1, %2" : "=v"(r) : "v"(lo), "v"(hi)); return r; }

struct EpiProj {
    static constexpr bool PERM = true, AFTER_DRAIN = false;
    bf16_t* PA; bf16_t* PG; bf16_t* PZ; const float* rstd; float qsa, qsb; bf16_t* KB; bf16_t* VB;
    __device__ __forceinline__ void operator()(const f32x4 (&acc)[2][2][4][2], const Unit& u, int wr, int wc, int fr, int fq) const {
        const int pn = u.pn; bf16_t* base; int ldc, colt; float sc = 1.f;
        if (pn < 10) { base = PA; ldc = 2560; colt = pn * 256; if (pn < 4) sc = qsa; }
        else if (pn < 18) { base = PG; ldc = 2048; colt = (pn - 10) * 256; if (pn < 12) sc = qsb; }
        else { base = PZ; ldc = 1024; colt = (pn - 18) * 256; }
        const int row0 = u.pm * BM + wr * 64 + fr, col0 = colt + wc * 32 + 8 * fq;
#pragma unroll
        for (int ai = 0; ai < 2; ++ai)
#pragma unroll
            for (int m = 0; m < 4; ++m) { const int row = row0 + ai * HALF + m * 16; const float rs = sc; bf16_t* rowp = base + (size_t)row * ldc + col0;
#pragma unroll
                for (int bj = 0; bj < 2; ++bj) { const f32x4 v0 = acc[ai][bj][m][0] * rs, v1 = acc[ai][bj][m][1] * rs;
                    u32x4 w; w.x = cvt_pk(v0[0], v0[1]); w.y = cvt_pk(v0[2], v0[3]); w.z = cvt_pk(v1[0], v1[1]); w.w = cvt_pk(v1[2], v1[3]);
                    if (pn == 4 || pn == 5) *(u32x4*)((pn == 4 ? KB : VB) + ((size_t)bj * 40960 + row) * 128 + wc * 32 + 8 * fq) = w;
                    else if (pn >= 18 || (pn >= 6 && pn < 10)) __builtin_nontemporal_store(w, (u32x4*)(rowp + bj * HALF));
                    else *(u32x4*)(rowp + bj * HALF) = w; } }
    }
};
struct EpiOut {
    static constexpr bool PERM = true, AFTER_DRAIN = false;
    bf16_t* O; float* ssq; int ldo;
    __device__ __forceinline__ void operator()(const f32x4 (&acc)[2][2][4][2], const Unit& u, int wr, int wc, int fr, int fq) const {
        const int row0 = u.pm * BM + wr * 64 + fr, col0 = u.pn * BM + wc * 32 + 8 * fq;
#pragma unroll
        for (int ai = 0; ai < 2; ++ai)
#pragma unroll
            for (int m = 0; m < 4; ++m) { const int row = row0 + ai * HALF + m * 16; bf16_t* rowp = O + (size_t)row * ldo + col0; float s = 0.f;
#pragma unroll
                for (int bj = 0; bj < 2; ++bj) { const f32x4 v0 = acc[ai][bj][m][0], v1 = acc[ai][bj][m][1];
                    s += (v0[0] * v0[0] + v0[1] * v0[1]) + (v0[2] * v0[2] + v0[3] * v0[3]) + (v1[0] * v1[0] + v1[1] * v1[1]) + (v1[2] * v1[2] + v1[3] * v1[3]);
                    u32x4 w; w.x = cvt_pk(v0[0], v0[1]); w.y = cvt_pk(v0[2], v0[3]); w.z = cvt_pk(v1[0], v1[1]); w.w = cvt_pk(v1[2], v1[3]);
                    *(u32x4*)(rowp + bj * HALF) = w; }
                s += __shfl_xor(s, 16); s += __shfl_xor(s, 32);
                if (fq == 0) ssq[(size_t)row * 32 + u.pn * 4 + wc] = s; }
    }
};
template <class Epi, class Sched, bool ALIGN_EPI = false, bool SP2 = false>
__device__ __forceinline__ void gemm_phase(PG8_LAS unsigned char* lds, const Gemm g, const Sched& S, const Epi& E) {
    const int tid = threadIdx.x, wid = __builtin_amdgcn_readfirstlane(tid >> 6), lane = tid & 63, wr = wid >> 2, wc = wid & 3, fr = lane & 15, fq = lane >> 4;
    const int K = g.K, nt = K / BK;
    unsigned voffA[2], voffB[2];
#pragma unroll
    for (int i = 0; i < 2; ++i) { int R, C; stage_rc(tid * 16 + i * 8192, R, C); const int Rb = Epi::PERM ? ((R & ~31) + perm32(R & 31)) : R;
        voffA[i] = (unsigned)(R * K + C) * 2u; voffB[i] = (unsigned)(Rb * K + C) * 2u; }
    const size_t kstep = (size_t)(BK * 2);
    const size_t hstep = (size_t)HALF * K * 2;
    const size_t tstep = 2 * hstep;
    const unsigned ldsw = (unsigned)wid * 1024u;
    const int aoff = lds_byte(wr * 64 + fr, fq * 8), boff = lds_byte(wc * 32 + fr, fq * 8);
#define PG8_SA(b, h) (((b) * 2 + (h)) * HTB)
#define PG8_SB(b, h) ((4 + (b) * 2 + (h)) * HTB)
#define PG8_STAGE(bufoff, gbase, voff) do { _Pragma("unroll") for (int _i = 0; _i < 2; ++_i) \
        __builtin_amdgcn_global_load_lds((const unsigned*)((const char*)(gbase) + (voff)[_i]), (PG8_LAS unsigned*)(lds + (bufoff) + ldsw + _i * 8192), 16, 0, 0); } while (0)
#define PG8_LDA(dst, b, h) do { _Pragma("unroll") for (int m = 0; m < 4; ++m) _Pragma("unroll") for (int k = 0; k < 2; ++k) dst[m][k] = *(const PG8_LAS bf16x8*)(lds + PG8_SA(b, h) + aoff + m * 2048 + k * 1024); } while (0)
#define PG8_LDB(dst, b, h) do { _Pragma("unroll") for (int n = 0; n < 2; ++n) _Pragma("unroll") for (int k = 0; k < 2; ++k) dst[n][k] = *(const PG8_LAS bf16x8*)(lds + PG8_SB(b, h) + boff + n * 2048 + k * 1024); } while (0)
#define PG8_MMA(ai, bj, At, Bt) do { __builtin_amdgcn_s_setprio(1); _Pragma("unroll") for (int m = 0; m < 4; ++m) _Pragma("unroll") for (int n = 0; n < 2; ++n) _Pragma("unroll") for (int k = 0; k < 2; ++k) \
        acc[ai][bj][m][n] = __builtin_amdgcn_mfma_f32_16x16x32_bf16(Bt[n][k], At[m][k], acc[ai][bj][m][n], 0, 0, 0); __builtin_amdgcn_s_setprio(0); } while (0)
#define PG8_WAIT_V(n) asm volatile("s_waitcnt vmcnt(" #n ")" ::: "memory")
#define PG8_WAIT_L(n) asm volatile("s_waitcnt lgkmcnt(" #n ")" ::: "memory")
#define PG8_BAR __builtin_amdgcn_s_barrier()
#define PG8_SCHED __builtin_amdgcn_sched_barrier(0)
    Unit cur, nxt; int ui = 0;
    if (!S.next(0, cur)) return;
    f32x4 acc[2][2][4][2];
#pragma unroll
    for (int a = 0; a < 2; ++a)
#pragma unroll
        for (int b = 0; b < 2; ++b)
#pragma unroll
            for (int m = 0; m < 4; ++m)
#pragma unroll
                for (int n = 0; n < 2; ++n) acc[a][b][m][n] = (f32x4){0.f, 0.f, 0.f, 0.f};
    bf16x8 At[4][2], B0[2][2], B1[2][2];
    const char* cA = (const char*)g.A + (size_t)cur.pm * tstep; const char* cB = (const char*)g.Bt + (size_t)cur.pn * tstep;
    S.a_ready(cur);
    if constexpr (SP2) {
        PG8_STAGE(PG8_SB(0, 0), cB, voffB); PG8_STAGE(PG8_SB(0, 1), cB + hstep, voffB); PG8_STAGE(PG8_SA(0, 0), cA, voffA); PG8_STAGE(PG8_SA(0, 1), cA + hstep, voffA);
        if (wr == 1) PG8_BAR;
        PG8_WAIT_V(2); PG8_BAR;
        PG8_STAGE(PG8_SB(1, 0), cB + kstep, voffB); PG8_STAGE(PG8_SA(1, 0), cA + kstep, voffA); PG8_STAGE(PG8_SB(1, 1), cB + hstep + kstep, voffB);
        PG8_WAIT_V(6); PG8_BAR;
    } else {
        PG8_STAGE(PG8_SB(0, 0), cB, voffB); PG8_STAGE(PG8_SA(0, 0), cA, voffA); PG8_STAGE(PG8_SB(0, 1), cB + hstep, voffB); PG8_STAGE(PG8_SA(0, 1), cA + hstep, voffA);
        if (wr == 1) PG8_BAR;
        PG8_WAIT_V(4); PG8_BAR;
        PG8_STAGE(PG8_SB(1, 0), cB + kstep, voffB); PG8_STAGE(PG8_SA(1, 0), cA + kstep, voffA); PG8_STAGE(PG8_SB(1, 1), cB + hstep + kstep, voffB);
        PG8_WAIT_V(6); PG8_BAR;
    }
    for (;;) {
        const bool has_next = S.next(ui + 1, nxt);
        const char* nA = has_next ? (const char*)g.A + (size_t)nxt.pm * tstep : cA; const char* nB = has_next ? (const char*)g.Bt + (size_t)nxt.pn * tstep : cB;
        for (int t = 0; t < nt; t += 2) {
            const bool last = (t == nt - 2);
            const char* a1 = cA + (size_t)(t + 1) * kstep;
            const char* a2 = last ? nA : cA + (size_t)(t + 2) * kstep; const char* b2 = last ? nB : cB + (size_t)(t + 2) * kstep;
            const char* a3 = a2 + kstep; const char* b3 = b2 + kstep;
            if (last && has_next) S.a_ready(nxt);
            if constexpr (SP2) {
            PG8_LDB(B0, 0, 0); PG8_LDB(B1, 0, 1); PG8_SCHED; PG8_LDA(At, 0, 0); PG8_STAGE(PG8_SA(1, 1), a1 + hstep, voffA);
            PG8_WAIT_V(8); PG8_WAIT_L(0); PG8_BAR; PG8_MMA(0, 0, At, B0); PG8_MMA(0, 1, At, B1); PG8_BAR; PG8_SCHED;
            PG8_LDA(At, 0, 1); PG8_STAGE(PG8_SB(0, 0), b2, voffB); PG8_STAGE(PG8_SB(0, 1), b2 + hstep, voffB); PG8_STAGE(PG8_SA(0, 0), a2, voffA);
            PG8_WAIT_V(8); PG8_WAIT_L(0); PG8_BAR; PG8_MMA(1, 0, At, B0); PG8_MMA(1, 1, At, B1); PG8_BAR; PG8_SCHED;
            PG8_LDB(B0, 1, 0); PG8_LDB(B1, 1, 1); PG8_SCHED; PG8_LDA(At, 1, 0); PG8_STAGE(PG8_SA(0, 1), a2 + hstep, voffA);
            PG8_WAIT_V(8); PG8_WAIT_L(0); PG8_BAR; PG8_MMA(0, 0, At, B0); PG8_MMA(0, 1, At, B1); PG8_BAR; PG8_SCHED;
            PG8_LDA(At, 1, 1); PG8_STAGE(PG8_SB(1, 0), b3, voffB); PG8_STAGE(PG8_SB(1, 1), b3 + hstep, voffB); PG8_STAGE(PG8_SA(1, 0), a3, voffA);
            PG8_WAIT_V(8); PG8_WAIT_L(0); PG8_BAR; PG8_MMA(1, 0, At, B0); PG8_MMA(1, 1, At, B1); PG8_BAR; PG8_SCHED;
            } else {
            PG8_LDB(B0, 0, 0); PG8_SCHED; PG8_LDA(At, 0, 0); PG8_STAGE(PG8_SA(1, 1), a1 + hstep, voffA);
            PG8_WAIT_L(8); PG8_BAR; PG8_WAIT_L(0); PG8_MMA(0, 0, At, B0); PG8_BAR; PG8_SCHED;
            PG8_LDB(B1, 0, 1); PG8_STAGE(PG8_SB(0, 0), b2, voffB);
            PG8_BAR; PG8_WAIT_L(0); PG8_MMA(0, 1, At, B1); PG8_BAR;
            PG8_LDA(At, 0, 1); PG8_STAGE(PG8_SA(0, 0), a2, voffA);
            PG8_BAR; PG8_WAIT_L(0); PG8_MMA(1, 0, At, B0); PG8_BAR; PG8_SCHED;
            PG8_STAGE(PG8_SB(0, 1), b2 + hstep, voffB);
            PG8_WAIT_V(6); PG8_BAR; PG8_MMA(1, 1, At, B1); PG8_BAR;
            PG8_LDB(B0, 1, 0); PG8_SCHED; PG8_LDA(At, 1, 0); PG8_STAGE(PG8_SA(0, 1), a2 + hstep, voffA);
            PG8_WAIT_L(8); PG8_BAR; PG8_WAIT_L(0); PG8_MMA(0, 0, At, B0); PG8_BAR; PG8_SCHED;
            PG8_LDB(B1, 1, 1); PG8_STAGE(PG8_SB(1, 0), b3, voffB);
            PG8_BAR; PG8_WAIT_L(0); PG8_MMA(0, 1, At, B1); PG8_BAR;
            PG8_LDA(At, 1, 1); PG8_STAGE(PG8_SA(1, 0), a3, voffA);
            PG8_BAR; PG8_WAIT_L(0); PG8_MMA(1, 0, At, B0); PG8_BAR; PG8_SCHED;
            PG8_STAGE(PG8_SB(1, 1), b3 + hstep, voffB);
            PG8_WAIT_V(6); PG8_BAR; PG8_MMA(1, 1, At, B1); PG8_BAR;
            }
        }
        if constexpr (ALIGN_EPI) { if (wr == 0) PG8_BAR; }
        if constexpr (!Epi::AFTER_DRAIN) { E(acc, cur, wr, wc, fr, fq); S.done(cur); }
        if (!has_next) break;
#pragma unroll
        for (int a = 0; a < 2; ++a)
#pragma unroll
            for (int b = 0; b < 2; ++b)
#pragma unroll
                for (int m = 0; m < 4; ++m)
#pragma unroll
                    for (int n = 0; n < 2; ++n) acc[a][b][m][n] = (f32x4){0.f, 0.f, 0.f, 0.f};
        cur = nxt; cA = nA; cB = nB; ++ui;
        if constexpr (ALIGN_EPI) { if (wr == 1) PG8_BAR; }
    }
    PG8_WAIT_V(0);
    if constexpr (!ALIGN_EPI) { if (wr == 0) PG8_BAR; }
    PG8_BAR;
    if constexpr (Epi::AFTER_DRAIN) { E.fused(acc, cur, wr, wc, fr, fq, lds, wid, lane); S.done(cur); }
#undef PG8_SA
#undef PG8_SB
#undef PG8_STAGE
#undef PG8_LDA
#undef PG8_LDB
#undef PG8_MMA
#undef PG8_WAIT_V
#undef PG8_WAIT_L
#undef PG8_BAR
#undef PG8_SCHED
}
}


DI void transpose_w(const float* __restrict__ w, const float* __restrict__ rowscale, bf16_t* __restrict__ out, int K, int N, int bid, int nb, LAS float* tile) {
    const int tid = threadIdx.x, nkt = K / 64, nnt = N / 32, ntile = nkt * nnt;
    for (int t0 = bid; t0 < ntile; t0 += 8 * nb) {
        __syncthreads();
        float v[8][4];
#pragma unroll
        for (int q = 0; q < 8; ++q) { const int t = t0 + q * nb; if (t < ntile) { const int k0 = (t % nkt) * 64, n0 = (t / nkt) * 32;
#pragma unroll
            for (int it = 0; it < 4; ++it) { const int i = it * 16 + (tid >> 5), j = tid & 31; v[q][it] = w[(size_t)(k0 + i) * N + n0 + j]; if (rowscale) v[q][it] *= rowscale[k0 + i]; } } }
#pragma unroll
        for (int q = 0; q < 8; ++q) { const int t = t0 + q * nb; if (t < ntile) {
#pragma unroll
            for (int it = 0; it < 4; ++it) { const int i = it * 16 + (tid >> 5), j = tid & 31; tile[q * 2080 + j * 65 + i] = v[q][it]; } } }
        __syncthreads();
#pragma unroll
        for (int q = 0; q < 8; ++q) { const int t = t0 + q * nb; if (t < ntile) { const int k0 = (t % nkt) * 64, n0 = (t / nkt) * 32;
            const int j = tid >> 4, ii = (tid & 15) * 4; const LAS float* tp = tile + q * 2080 + j * 65 + ii;
            u32x2 o; o.x = cvt_pk_bf16(tp[0], tp[1]); o.y = cvt_pk_bf16(tp[2], tp[3]);
            *(u32x2*)(out + (size_t)(n0 + j) * K + k0 + ii) = o; } }
    }
}
DI const float* x_row(const Params& P, int row) { return row < NPROMPT ? P.x_prompt + (size_t)row * DM : P.x_sample + (size_t)(row - NPROMPT) * DM; }

DI void phase_prep(const Params& P, int bid, int nb, LAS unsigned char* lds) {
    LAS float* tile = (LAS float*)lds;
    for (int l = 0; l < 2; ++l) {
        transpose_w(P.w_in + (size_t)l * DM * NIN, P.norm_pre + l * DM, (bf16_t*)(P.ws + WS_WIN) + (size_t)l * NIN * DM, DM, NIN, bid, nb, tile);
        transpose_w(P.w_out + (size_t)l * DM * DM, nullptr, (bf16_t*)(P.ws + WS_WOUT) + (size_t)l * DM * DM, DM, DM, bid, nb, tile);
    }
    const int wid = threadIdx.x >> 6, lane = threadIdx.x & 63;
    bf16_t* XB = (bf16_t*)(P.ws + WS_XB); float* RSTD = (float*)(P.ws + WS_RSTD);
    for (int row0 = (bid * 8 + wid) * 2; row0 < MTOK; row0 += nb * 16) {
        f32x4 v[2][8];
#pragma unroll
        for (int u = 0; u < 2; ++u) { const float* xr = x_row(P, row0 + u);
#pragma unroll
            for (int it = 0; it < 8; ++it) v[u][it] = __builtin_nontemporal_load((const f32x4*)(xr + (it * 64 + lane) * 4)); }
#pragma unroll
        for (int u = 0; u < 2; ++u) { const int row = row0 + u; float ss = 0.f;
#pragma unroll
            for (int it = 0; it < 8; ++it) { const f32x4 t = v[u][it]; ss += (t[0] * t[0] + t[1] * t[1]) + (t[2] * t[2] + t[3] * t[3]); }
            const float rs = rsqrtf(wave_sum(ss) * (1.0f / DM) + EPS);
#pragma unroll
            for (int it = 0; it < 8; ++it) { const int c = (it * 64 + lane) * 4; const f32x4 t = v[u][it] * rs;
                u32x2 o; o.x = cvt_pk_bf16(t[0], t[1]); o.y = cvt_pk_bf16(t[2], t[3]); *(u32x2*)(XB + (size_t)row * DM + c) = o; } }
    }
    if (bid == 0) { unsigned* bw = (unsigned*)(P.ws + WS_CTL); for (int i = threadIdx.x; i < 4096; i += NTHR) bw[i] = 0u; }
    if (bid == 0) {
        float* tab = (float*)(P.ws + WS_TAB);
        for (int i = threadIdx.x; i < 8 * 257; i += NTHR) { const int h = i / 257, rel = i % 257 - 128, n = rel < 0 ? -rel : rel;
            const int bk = n < 8 ? n : 8 + (n >= 12) + (n >= 16) + (n >= 23) + (n >= 32) + (n >= 46) + (n >= 64) + (n >= 91);
            tab[i] = P.rel_bias[((rel > 0 ? 16 : 0) + bk) * 8 + h] * LOG2E; }
    }
}

DI void phase_gates(const Params& P, int l, int bid, int nb, LAS unsigned char* lds) {
    const int wid = threadIdx.x >> 6, lane = threadIdx.x & 63, r = lane & 31, h = lane >> 5;
    const bf16_t* XB = (const bf16_t*)(P.ws + WS_XB); const bf16_t* Wg = (const bf16_t*)(P.ws + WS_WIN) + ((size_t)l * NIN + NMAIN) * DM;
    float* LR = (float*)(P.ws + WS_LR);
    __syncthreads();
#pragma unroll 4
    for (int q = 0; q < 16; ++q) { const int e = q * 512 + threadIdx.x, n = e >> 8, c16 = e & 255;
        *(LAS u32x4*)(lds + n * 4112 + c16 * 16) = *(const u32x4*)(Wg + (size_t)n * DM + c16 * 8); }
    __syncthreads();
    const LAS unsigned char* bp = lds + r * 4112 + 64 * h;
    for (int t = bid * 8 + wid; t < MTOK / 32; t += nb * 8) {
        const bf16_t* ap = XB + (size_t)(t * 32 + r) * DM + 32 * h;
        f32x16 acc; for (int i = 0; i < 16; ++i) acc[i] = 0.f;
        bf16x8 a[8], an[8];
#pragma unroll
        for (int j = 0; j < 8; ++j) a[j] = *(const bf16x8*)(ap + (j >> 2) * 64 + 8 * (j & 3));
#pragma unroll 1
        for (int kb = 0; kb < DM; kb += 128) {
            if (kb + 128 < DM) {
#pragma unroll
                for (int j = 0; j < 8; ++j) an[j] = *(const bf16x8*)(ap + kb + 128 + (j >> 2) * 64 + 8 * (j & 3)); }
#pragma unroll
            for (int j = 0; j < 8; ++j) { const bf16x8 bj = *(const LAS bf16x8*)(bp + (kb + (j >> 2) * 64 + 8 * (j & 3)) * 2);
                acc = __builtin_amdgcn_mfma_f32_32x32x16_bf16(a[j], bj, acc, 0, 0, 0); }
#pragma unroll
            for (int j = 0; j < 8; ++j) a[j] = an[j];
        }
#pragma unroll
        for (int i = 0; i < 16; ++i) { const int row = t * 32 + (i & 3) + 8 * (i >> 2) + 4 * h; LR[(size_t)row * 32 + r] = acc[i]; }
    }
    __syncthreads();
}

DI void phase_inproj(const Params& P, int l, int bid, int nb, LAS unsigned char* lds) {
    pg8::Gemm g{(const bf16_t*)(P.ws + WS_XB), (const bf16_t*)(P.ws + WS_WIN) + (size_t)l * NIN * DM, MTOK, NMAIN, DM};
    pg8::StaticOrder S; S.init(MTOK, NMAIN, nb, bid);
    pg8::EpiProj E{(bf16_t*)(P.ws + WS_PA), (bf16_t*)(P.ws + WS_PG), (bf16_t*)(P.ws + WS_PZ), (const float*)(P.ws + WS_RSTD), QSCALE_A, QSCALE_B, (bf16_t*)(P.ws + WS_KB), (bf16_t*)(P.ws + WS_VB)};
    pg8::gemm_phase<pg8::EpiProj, pg8::StaticOrder, true, true>(lds, g, S, E);
}
DI void phase_outproj(const Params& P, int l, int bid, int nb, LAS unsigned char* lds) {
    pg8::Gemm g{(const bf16_t*)(P.ws + WS_XB), (const bf16_t*)(P.ws + WS_WOUT) + (size_t)l * DM * DM, MTOK, DM, DM};
    pg8::StaticOrder S; S.init(MTOK, DM, nb, bid);
    pg8::EpiOut E{l == 0 ? (bf16_t*)P.out : (bf16_t*)(P.ws + WS_MIXOUT), (float*)(P.ws + (l == 0 ? WS_SSQ0 : WS_SSQ)), l == 0 ? 4096 : 2048};
    pg8::gemm_phase<pg8::EpiOut, pg8::StaticOrder, true, true>(lds, g, S, E);
}

DI void phase_post(const Params& P, int l, int bid, int nb) {
    const int wid = threadIdx.x >> 6, lane = threadIdx.x & 63;
    const bf16_t* M0 = (const bf16_t*)P.out; const bf16_t* M1 = (const bf16_t*)(P.ws + WS_MIXOUT);
    const float* S0 = (const float*)(P.ws + WS_SSQ0); const float* S1 = (const float*)(P.ws + WS_SSQ);
    bf16_t* XB = (bf16_t*)(P.ws + WS_XB);
    f32x4 w0[8], w1[8];
#pragma unroll
    for (int it = 0; it < 8; ++it) { w0[it] = *(const f32x4*)(P.norm_post + (it * 64 + lane) * 4); w1[it] = l == 1 ? *(const f32x4*)(P.norm_post + DM + (it * 64 + lane) * 4) : w0[it]; }
    for (int row0 = (bid * 8 + wid) * 2; row0 < MTOK; row0 += nb * 16) {
        f32x4 b[2][8]; u32x2 m0[2][8], m1[2][8]; float s0[2], s1[2];
#pragma unroll
        for (int u = 0; u < 2; ++u) { const int row = row0 + u; const float* br = x_row(P, row);
            s0[u] = lane < 32 ? S0[(size_t)row * 32 + lane] : 0.f; s1[u] = (l == 1 && lane < 32) ? S1[(size_t)row * 32 + lane] : 0.f;
#pragma unroll
            for (int it = 0; it < 8; ++it) { const int c = (it * 64 + lane) * 4; b[u][it] = __builtin_nontemporal_load((const f32x4*)(br + c)); m0[u][it] = __builtin_nontemporal_load((const u32x2*)(M0 + (size_t)row * 4096 + c));
                if (l == 1) m1[u][it] = __builtin_nontemporal_load((const u32x2*)(M1 + (size_t)row * DM + c)); } }
        asm volatile("" ::: "memory");
#pragma unroll
        for (int u = 0; u < 2; ++u) { const int row = row0 + u;
            const float r0 = rsqrtf(wave_sum(s0[u]) * (1.0f / DM) + EPS); float ss = 0.f;
#pragma unroll
            for (int it = 0; it < 8; ++it) { const int c = (it * 64 + lane) * 4; const f32x4 w = w0[it]; const f32x4 bb = b[u][it]; const u32x2 m = m0[u][it];
                f32x4 y; y[0] = bb[0] + bflo(m.x) * r0 * w[0]; y[1] = bb[1] + bfhi(m.x) * r0 * w[1]; y[2] = bb[2] + bflo(m.y) * r0 * w[2]; y[3] = bb[3] + bfhi(m.y) * r0 * w[3];
                b[u][it] = y; ss += (y[0] * y[0] + y[1] * y[1]) + (y[2] * y[2] + y[3] * y[3]); }
            if (l == 0) { const float rs = rsqrtf(wave_sum(ss) * (1.0f / DM) + EPS);
#pragma unroll
                for (int it = 0; it < 8; ++it) { const int c = (it * 64 + lane) * 4; const f32x4 y = b[u][it] * rs;
                    u32x2 o; o.x = cvt_pk_bf16(y[0], y[1]); o.y = cvt_pk_bf16(y[2], y[3]); *(u32x2*)(XB + (size_t)row * DM + c) = o; } }
            else { const float r1 = rsqrtf(wave_sum(s1[u]) * (1.0f / DM) + EPS); float* orow = P.out + (size_t)row * DM;
#pragma unroll
                for (int it = 0; it < 8; ++it) { const int c = (it * 64 + lane) * 4; const f32x4 w = w1[it]; const f32x4 y1 = b[u][it]; const u32x2 m = m1[u][it];
                    f32x4 y; y[0] = y1[0] + bflo(m.x) * r1 * w[0]; y[1] = y1[1] + bfhi(m.x) * r1 * w[1]; y[2] = y1[2] + bflo(m.y) * r1 * w[2]; y[3] = y1[3] + bfhi(m.y) * r1 * w[3];
                    __builtin_nontemporal_store(y, (f32x4*)(orow + c)); } } }
    }
}

DI float silu_fast(float z) { return z * __builtin_amdgcn_rcpf(1.0f + __builtin_amdgcn_exp2f(-z * LOG2E)); }
DI void phase_fixup(const Params& P, int l, int bid, int nb) {
    const int wid = threadIdx.x >> 6, lane = threadIdx.x & 63;
    const bf16_t* OF = (const bf16_t*)(P.ws + WS_OFB); const bf16_t* OB = OF + (size_t)MTOK * 1024; const bf16_t* PZ = (const bf16_t*)(P.ws + WS_PZ);
    bf16_t* MI = (bf16_t*)(P.ws + WS_XB); const float* gn = P.gla_norm + l * 256 + (lane & 31) * 8;
    const f32x4 gw0 = *(const f32x4*)gn, gw1 = *(const f32x4*)(gn + 4);
    for (int tok0 = (bid * 8 + wid) * 2; tok0 < MTOK; tok0 += nb * 16) {
        u32x4 a[2][2], b[2][2], z[2][2];
#pragma unroll
        for (int u = 0; u < 2; ++u)
#pragma unroll
            for (int it = 0; it < 2; ++it) { const size_t off = (size_t)(tok0 + u) * 1024 + it * 512 + lane * 8; a[u][it] = __builtin_nontemporal_load((const u32x4*)(OF + off)); b[u][it] = __builtin_nontemporal_load((const u32x4*)(OB + off)); z[u][it] = __builtin_nontemporal_load((const u32x4*)(PZ + off)); }
#pragma unroll
        for (int u = 0; u < 2; ++u)
#pragma unroll
        for (int it = 0; it < 2; ++it) { float o[8];
#pragma unroll
            for (int q = 0; q < 4; ++q) { o[2 * q] = bflo(a[u][it][q]) + bflo(b[u][it][q]); o[2 * q + 1] = bfhi(a[u][it][q]) + bfhi(b[u][it][q]); }
            float ss = 0.f;
#pragma unroll
            for (int q = 0; q < 8; ++q) ss += o[q] * o[q];
#pragma unroll
            for (int m = 16; m >= 1; m >>= 1) ss += __shfl_xor(ss, m);
            const float r = rsqrtf(ss * (1.0f / 256.f) + EPS);
            u32x4 w;
#pragma unroll
            for (int q = 0; q < 4; ++q) { const float g0 = q < 2 ? gw0[2 * q] : gw1[2 * q - 4], g1 = q < 2 ? gw0[2 * q + 1] : gw1[2 * q - 3];
                w[q] = cvt_pk_bf16(o[2 * q] * r * g0 * silu_fast(bflo(z[u][it][q])), o[2 * q + 1] * r * g1 * silu_fast(bfhi(z[u][it][q]))); }
            *(u32x4*)(MI + (size_t)(tok0 + u) * DM + 1024 + it * 512 + lane * 8) = w; }
    }
}

#define KSWZ(row, colB) ((row) * 256 + ((colB) ^ (((row) & 7) << 4)))
#define SBAR() __builtin_amdgcn_sched_barrier(0)
DI int crow(int r, int hi) { return (r & 3) + 8 * (r >> 2) + 4 * hi; }
DI int v_st(int k, int c) { const int kk = (k & ~0xC) | ((k & 4) << 1) | ((k & 8) >> 1); return ((kk >> 3) * 4 + (c >> 5)) * 512 + ((kk & 7) * 32 + (c & 31)) * 2; }
DI int v_rd_base(int lane) { return ((lane & 3) << 3) | (((lane >> 2) & 3) << 6) | (((lane >> 4) & 1) << 5) | (((lane >> 5) & 1) << 8); }
constexpr int v_rd_off(int d0, int ks, int half) { return d0 * 512 + ks * 4096 + half * 2048; }
template <int OFF> DI s16x4 tr_read(int vb) { s16x4 r; asm volatile("ds_read_b64_tr_b16 %0, %1 offset:%2" : "=&v"(r) : "v"(vb), "i"(OFF) : "memory"); return r; }
template <int D0> DI void pv_one(f32x16& od, int vb, bf16x8 pa0, bf16x8 pa1, bf16x8 pa2, bf16x8 pa3) {
    const s16x4 l0 = tr_read<v_rd_off(D0, 0, 0)>(vb), h0 = tr_read<v_rd_off(D0, 0, 1)>(vb), l1 = tr_read<v_rd_off(D0, 1, 0)>(vb), h1 = tr_read<v_rd_off(D0, 1, 1)>(vb);
    const s16x4 l2 = tr_read<v_rd_off(D0, 2, 0)>(vb), h2 = tr_read<v_rd_off(D0, 2, 1)>(vb), l3 = tr_read<v_rd_off(D0, 3, 0)>(vb), h3 = tr_read<v_rd_off(D0, 3, 1)>(vb);
    asm volatile("s_waitcnt lgkmcnt(0)" ::: "memory"); SBAR();
#define PKV(L, H) (bf16x8){L[0], L[1], L[2], L[3], H[0], H[1], H[2], H[3]}
    od = __builtin_amdgcn_mfma_f32_32x32x16_bf16(PKV(l0, h0), pa0, od, 0, 0, 0);
    od = __builtin_amdgcn_mfma_f32_32x32x16_bf16(PKV(l1, h1), pa1, od, 0, 0, 0);
    od = __builtin_amdgcn_mfma_f32_32x32x16_bf16(PKV(l2, h2), pa2, od, 0, 0, 0);
    od = __builtin_amdgcn_mfma_f32_32x32x16_bf16(PKV(l3, h3), pa3, od, 0, 0, 0);
#undef PKV
}
DI void qkt(f32x16& p0, f32x16& p1, const LAS char* Ks, const bf16x8* qr, int r32, int hi) {
    for (int i = 0; i < 16; ++i) { p0[i] = 0.f; p1[i] = 0.f; }
#pragma unroll
    for (int d0 = 0; d0 < 8; ++d0) { const int cb = (d0 * 16 + hi * 8) * 2;
        const bf16x8 b0 = *(const LAS bf16x8*)(Ks + KSWZ(r32, cb));
        const bf16x8 b1 = *(const LAS bf16x8*)(Ks + KSWZ(32 + r32, cb));
        p0 = __builtin_amdgcn_mfma_f32_32x32x16_bf16(b0, qr[d0], p0, 0, 0, 0);
        p1 = __builtin_amdgcn_mfma_f32_32x32x16_bf16(b1, qr[d0], p1, 0, 0, 0); }
}
constexpr int AT_BUF = 65536, AT_TAB = 131072, AT_END = AT_TAB + 8 * 512 * 4;
constexpr int AT_NITEM = NSEQ * 32 * 2 * 2;

DI void phase_attn(const Params& P, int l, LAS unsigned char* lds) {
    const int tid = threadIdx.x, wid = __builtin_amdgcn_readfirstlane(tid >> 6), lane = tid & 63, r32 = lane & 31, hi = lane >> 5;
    const bf16_t* PA = (const bf16_t*)(P.ws + WS_PA); bf16_t* MI = (bf16_t*)(P.ws + WS_XB);
    LAS float* tab = (LAS float*)(lds + AT_TAB);
    __syncthreads();
    { const float* gt = (const float*)(P.ws + WS_TAB);
      for (int i = tid; i < 8 * 512; i += NTHR) { const int h = i >> 9, idx = (i & 511) - 96; tab[i] = (idx >= 0 && idx <= 256) ? gt[h * 257 + idx] : -1e30f; } }
    const int im = wid >> 1, hs = im & 1, isV = im >> 1;
    int soff[8];
#pragma unroll
    for (int q = 0; q < 8; ++q) { const int pp = (wid & 1) * 8 + q, s = pp * 64 + lane;
        if (!isV) { const int row = s >> 4, ch = (s & 15) ^ (row & 7); soff[q] = (hs * 64 + row) * 128 + ch * 8; }
        else { const int o = s * 16, st = o >> 9, wi = o & 511, kk = (st >> 2) * 8 + (wi >> 6), k = (kk & ~0xC) | ((kk & 4) << 1) | ((kk & 8) >> 1), c = (st & 3) * 32 + ((wi & 63) >> 1);
            soff[q] = (hs * 64 + k) * 128 + c; } }
    const int ldsp = im * 16384 + (wid & 1) * 8192;
    const bf16_t* KVB = (const bf16_t*)(P.ws + (isV ? WS_VB : WS_KB));
#define AT_ISSUE(item_, tile_, buf_) do { const int hk_ = ((item_) >> 1) & 1, n_ = ((item_) >> 2) & 31, sq_ = (item_) >> 7; \
        const bf16_t* src_ = KVB + ((size_t)hk_ * MTOK + (size_t)sq_ * SEQL + (n_ - 1 + (tile_)) * 128) * 128; \
        _Pragma("unroll") for (int q_ = 0; q_ < 8; ++q_) __builtin_amdgcn_global_load_lds((const unsigned*)(src_ + soff[q_]), (LAS unsigned*)(lds + (buf_) * AT_BUF + ldsp + q_ * 1024), 16, 0, 0); } while (0)
    const int vbl = (int)(unsigned)(uintptr_t)lds + 32768 + v_rd_base(lane);
    unsigned* qctr = (unsigned*)(P.ws + WS_CTL) + 3584 + 64 * l;
    volatile LAS int* slot = (volatile LAS int*)(lds + AT_END);
    if (tid == 0) { const int a0 = (int)__hip_atomic_fetch_add(qctr, 1u, __ATOMIC_RELAXED, __HIP_MEMORY_SCOPE_AGENT); const int a1 = (int)__hip_atomic_fetch_add(qctr, 1u, __ATOMIC_RELAXED, __HIP_MEMORY_SCOPE_AGENT); slot[0] = a0; slot[1] = a1; }
    __syncthreads();
    int item = slot[0], inext = slot[1]; int pend = AT_NITEM;
    if (item >= AT_NITEM) return;
    int e = 0;
    { const int n0 = (item >> 2) & 31; __syncthreads(); AT_ISSUE(item, n0 == 0 ? 1 : 0, 0); }
    bf16x8 qr[8];
#define AT_QLOAD(item_) do { const int half_ = (item_) & 1, hk_ = ((item_) >> 1) & 1, n_ = ((item_) >> 2) & 31, sq_ = (item_) >> 7; \
        const int g_ = hk_ * 4 + half_ * 2 + (wid >> 2), rq_ = n_ * 128 + ((wid & 3) ^ ((wid >> 2) << 1)) * 32; \
        const bf16_t* qp_ = PA + ((size_t)sq_ * SEQL + rq_ + r32) * 2560 + g_ * 128 + hi * 8; \
        _Pragma("unroll") for (int d0_ = 0; d0_ < 8; ++d0_) qr[d0_] = *(const bf16x8*)(qp_ + d0_ * 16); } while (0)
    AT_QLOAD(item);
    for (; item < AT_NITEM; ) {
        const int half = item & 1, hk = (item >> 1) & 1, n = (item >> 2) & 31, sq = item >> 7;
        const int g = hk * 4 + half * 2 + (wid >> 2), rq = n * 128 + ((wid & 3) ^ ((wid >> 2) << 1)) * 32;
        const size_t tok = (size_t)sq * SEQL + rq + r32;

        float m_run = P.sink[l * 8 + g] * LOG2E, l_run = 1.f;
        f32x16 o[4]; for (int d = 0; d < 4; ++d) for (int i = 0; i < 16; ++i) o[d][i] = 0.f;
        const int t_lo = n == 0 ? 1 : 0, t_hi = n == 31 ? 2 : 3;
        const size_t tokw = (size_t)sq * SEQL + rq;
        const bf16_t* zp = PA + (tokw + (lane >> 4)) * 2560 + 1536 + g * 128 + (lane & 15) * 8; u32x4 zz[8];
        const LAS float* tg = tab + g * 512 + 96 + 128 - r32;
        for (int t = t_lo; t < t_hi; ++t, ++e) {
            asm volatile("s_waitcnt vmcnt(0)" ::: "memory");
            if (t == t_lo + 1 && tid == 0) slot[2] = pend;
            asm volatile("s_waitcnt lgkmcnt(0)" ::: "memory");
            __builtin_amdgcn_s_barrier();
            asm volatile("" ::: "memory");
            if (t == t_lo && tid == 0) pend = (int)__hip_atomic_fetch_add(qctr, 1u, __ATOMIC_RELAXED, __HIP_MEMORY_SCOPE_AGENT);
            {
              if (t + 1 < t_hi) AT_ISSUE(item, t + 1, (e + 1) & 1);
              else if (inext < AT_NITEM) { const int ni = inext; AT_ISSUE(ni, (((ni >> 2) & 31) == 0 ? 1 : 0), (e + 1) & 1); }
              if (t + 1 == t_hi) {
#pragma unroll
                  for (int it = 0; it < 4; ++it) zz[it] = *(const u32x4*)(zp + (size_t)it * 4 * 2560); } }
            const LAS char* Bf = (const LAS char*)lds + (e & 1) * AT_BUF;
#pragma unroll
            for (int h2 = 0; h2 < 2; ++h2) {
                const int kp0 = (n - 1 + t) * 128 + h2 * 64;
                if (kp0 + 63 >= rq - 128 && kp0 <= rq + 159) {
                    f32x16 p0, p1;
                    qkt(p0, p1, Bf + h2 * 16384, qr, r32, hi);
                    const LAS float* tq = tg + (kp0 - rq);
                    float pmax = -1e30f;
#pragma unroll
                    for (int r = 0; r < 16; ++r) { p0[r] += tq[crow(r, hi)]; p1[r] += tq[32 + crow(r, hi)]; pmax = fmaxf(pmax, fmaxf(p0[r], p1[r])); }
                    pmax = fmaxf(pmax, __shfl_xor(pmax, 32));
                    float mn = m_run, alpha = 1.f;
                    if (!__all(pmax - m_run <= 8.f)) { mn = fmaxf(m_run, pmax); alpha = __builtin_amdgcn_exp2f(m_run - mn); m_run = mn; }
                    float ps = 0.f;
#pragma unroll
                    for (int r = 0; r < 16; ++r) { p0[r] = __builtin_amdgcn_exp2f(p0[r] - mn); p1[r] = __builtin_amdgcn_exp2f(p1[r] - mn); ps += p0[r] + p1[r]; }
                    ps += __shfl_xor(ps, 32);
                    l_run = l_run * alpha + ps;
                    bf16x8 pa0, pa1, pa2, pa3;
#define PK4(Pv, BASE, OUT) do { unsigned a0 = cvt_pk_bf16(Pv[BASE + 0], Pv[BASE + 1]), a1 = cvt_pk_bf16(Pv[BASE + 2], Pv[BASE + 3]); \
                    unsigned b0_ = cvt_pk_bf16(Pv[BASE + 4], Pv[BASE + 5]), b1_ = cvt_pk_bf16(Pv[BASE + 6], Pv[BASE + 7]); \
                    auto r0_ = __builtin_amdgcn_permlane32_swap(a0, b0_, false, false); auto r1_ = __builtin_amdgcn_permlane32_swap(a1, b1_, false, false); \
                    u32x4 w_ = {r0_[0], r1_[0], r0_[1], r1_[1]}; OUT = __builtin_bit_cast(bf16x8, w_); } while (0)
                    PK4(p0, 0, pa0); PK4(p0, 8, pa1); PK4(p1, 0, pa2); PK4(p1, 8, pa3);
#undef PK4
                    if (__any(alpha < 1.f)) {
#pragma unroll
                        for (int d = 0; d < 4; ++d)
#pragma unroll
                            for (int r = 0; r < 16; ++r) o[d][r] *= alpha; }
                    const int vb = vbl + (e & 1) * AT_BUF + h2 * 16384;
                    pv_one<0>(o[0], vb, pa0, pa1, pa2, pa3); pv_one<1>(o[1], vb, pa0, pa1, pa2, pa3); pv_one<2>(o[2], vb, pa0, pa1, pa2, pa3); pv_one<3>(o[3], vb, pa0, pa1, pa2, pa3);
                }
            }
        }
        if (inext < AT_NITEM) AT_QLOAD(inext);
        const float rl = __builtin_amdgcn_rcpf(l_run);
#pragma unroll
        for (int it = 4; it < 8; ++it) zz[it] = *(const u32x4*)(zp + (size_t)it * 4 * 2560);
        asm volatile("s_waitcnt lgkmcnt(0)" ::: "memory"); __builtin_amdgcn_s_barrier(); asm volatile("" ::: "memory");
        { LAS unsigned char* stg = lds + ((e & 1) ^ 1) * AT_BUF + wid * 8192; int rsw = r32 & 15, lsw = lane; asm volatile("" : "+v"(rsw), "+v"(lsw));
#pragma unroll
          for (int d0 = 0; d0 < 4; ++d0)
#pragma unroll
              for (int a4 = 0; a4 < 4; ++a4) { u32x2 w; w.x = cvt_pk_bf16(o[d0][a4 * 4 + 0] * rl, o[d0][a4 * 4 + 1] * rl); w.y = cvt_pk_bf16(o[d0][a4 * 4 + 2] * rl, o[d0][a4 * 4 + 3] * rl);
                  *(LAS u32x2*)(stg + r32 * 256 + (((d0 * 4 + a4) ^ rsw) << 4) + hi * 8) = w; }
          asm volatile("s_waitcnt lgkmcnt(0)" ::: "memory");
          bf16_t* op = MI + (tokw + (lane >> 4)) * DM + g * 128 + (lane & 15) * 8;
#pragma unroll
          for (int it = 0; it < 8; ++it) { const int row = it * 4 + (lsw >> 4);
              const u32x4 ov = *(const LAS u32x4*)(stg + row * 256 + (((lsw & 15) ^ (row & 15)) << 4)); const u32x4 z = zz[it]; u32x4 w;
#pragma unroll
              for (int q = 0; q < 4; ++q) w[q] = cvt_pk_bf16(bflo(ov[q]) * silu_fast(bflo(z[q])), bfhi(ov[q]) * silu_fast(bfhi(z[q])));
              *(u32x4*)(op + (size_t)it * 4 * DM) = w; if (it & 1) __builtin_amdgcn_sched_barrier(0); } }
        item = inext; inext = slot[2];
    }
#undef AT_ISSUE
#undef AT_QLOAD
    asm volatile("s_waitcnt vmcnt(0)" ::: "memory");
    __syncthreads();
}


typedef float f32x2 __attribute__((ext_vector_type(2)));
typedef __bf16 bfx2 __attribute__((ext_vector_type(2)));
DI unsigned pkbf(float a, float b) { f32x2 v = {a, b}; bfx2 r = __builtin_convertvector(v, bfx2); return __builtin_bit_cast(unsigned, r); }

constexpr int PP_LR = 0, PP_V = 8192, PP_QD = 8192 + 32768, PP_KD = PP_QD + 32768, PP_W = PP_KD + 32768;
DI float logsigmoid_fast(float z) { return fminf(z, 0.f) - 0.6931471805599453f * __builtin_amdgcn_logf(1.0f + __builtin_amdgcn_exp2f(-fabsf(z) * LOG2E)); }

DI void phase_gla_prep(const Params& P, int l, int bid, int nb, LAS unsigned char* lds) {
    const int tid = threadIdx.x, wid = tid >> 6, lane = tid & 63, dpl = lane & 7, rg = lane >> 3, r32 = lane & 31, hi = lane >> 5;
    const bf16_t* PG = (const bf16_t*)(P.ws + WS_PG); const float* LR = (const float*)(P.ws + WS_LR);
    const int c0 = wid * 16 + dpl * 2;
    const int p0 = (c0 & ~15) | (c0 & 3) | ((c0 & 4) << 1) | ((c0 & 8) >> 1);
    int hcur = -1;
    f32x4 n_lr; unsigned n_q[8], n_k[8];
#define PP_FETCH(task_) do { const int c_ = (task_) >> 2, h_ = (task_) & 3; const size_t t0_ = (size_t)c_ * 64; \
        n_lr = *(const f32x4*)(LR + t0_ * 32 + tid * 4); \
        _Pragma("unroll") for (int r_ = 0; r_ < 8; ++r_) { const bf16_t* rp_ = PG + (t0_ + rg * 8 + r_) * 2048 + h_ * 128 + c0; n_q[r_] = *(const unsigned*)rp_; n_k[r_] = *(const unsigned*)(rp_ + 512); } } while (0)
    if (bid < 2560) PP_FETCH(bid);
    f32x2 bbs[2] = {{0.f, 0.f}, {0.f, 0.f}};
    for (int task = bid; task < 2560; task += nb) {
        const int c = task >> 2, h = task & 3;
        __syncthreads();
        if (h != hcur) { hcur = h;
            for (int e = tid; e < 2 * 16 * 128; e += NTHR) { const int dir = e >> 11, k = (e >> 7) & 15, cc = e & 127;
                ((LAS float*)(lds + PP_W))[e] = (dir ? P.w_gk_b : P.w_gk_f)[(size_t)l * 16 * 512 + k * 512 + h * 128 + cc]; }
            bbs[0] = *(const f32x2*)(P.b_gk_f + l * 512 + h * 128 + c0); bbs[1] = *(const f32x2*)(P.b_gk_b + l * 512 + h * 128 + c0); }
        *(LAS f32x4*)(lds + PP_LR + tid * 16) = n_lr;
        unsigned qw[8], kw[8];
#pragma unroll
        for (int r = 0; r < 8; ++r) { qw[r] = n_q[r]; kw[r] = n_k[r]; }
        asm volatile("" : "+v"(qw[0]), "+v"(qw[1]), "+v"(qw[2]), "+v"(qw[3]), "+v"(qw[4]), "+v"(qw[5]), "+v"(qw[6]), "+v"(qw[7]), "+v"(kw[0]), "+v"(kw[1]), "+v"(kw[2]), "+v"(kw[3]), "+v"(kw[4]), "+v"(kw[5]), "+v"(kw[6]), "+v"(kw[7]) :: "memory");
        __builtin_amdgcn_sched_barrier(0);
        { const int wu = __builtin_amdgcn_readfirstlane(wid);
#pragma unroll
          for (int q = 0; q < 4; ++q) { const int row = wu * 8 + q * 2 + (lane >> 5);
              __builtin_amdgcn_global_load_lds((const unsigned*)(PG + ((size_t)c * 64 + row) * 2048 + 1024 + h * 256 + (lane & 31) * 8), (LAS unsigned*)(lds + PP_V + (wu * 8 + q * 2) * 512), 16, 0, 0); } }
        if (task + nb < 2560) PP_FETCH(task + nb);
        asm volatile("s_waitcnt lgkmcnt(0)" ::: "memory"); __builtin_amdgcn_s_barrier(); asm volatile("" ::: "memory");
#pragma unroll 1
        for (int dir = 0; dir < 2; ++dir) {
            float w0[16], w1[16];
#pragma unroll
            for (int k = 0; k < 16; ++k) { const f32x2 t = *(const LAS f32x2*)(lds + PP_W + ((dir * 16 + k) * 128 + c0) * 4); w0[k] = t.x; w1[k] = t.y; }
            const f32x2 bb = dir ? bbs[1] : bbs[0];
            float g0[8], g1[8];
#pragma unroll
            for (int r = 0; r < 8; ++r) { float z0 = bb.x, z1 = bb.y; const LAS float* lr = (const LAS float*)(lds + PP_LR) + (rg * 8 + r) * 32 + dir * 16;
#pragma unroll
                for (int k4 = 0; k4 < 4; ++k4) { const f32x4 t = *(const LAS f32x4*)(lr + k4 * 4);
#pragma unroll
                    for (int u = 0; u < 4; ++u) { z0 += t[u] * w0[k4 * 4 + u]; z1 += t[u] * w1[k4 * 4 + u]; } }
                g0[r] = logsigmoid_fast(z0) * 0.0625f; g1[r] = logsigmoid_fast(z1) * 0.0625f; __builtin_amdgcn_sched_barrier(0); }
            float tot0, tot1;
            if (dir == 0) {
#pragma unroll
                for (int r = 1; r < 8; ++r) { g0[r] += g0[r - 1]; g1[r] += g1[r - 1]; }
                float s0 = g0[7], s1 = g1[7];
#pragma unroll
                for (int o = 8; o < 64; o <<= 1) { const float t0 = __shfl_up(s0, o), t1 = __shfl_up(s1, o); if (lane >= o) { s0 += t0; s1 += t1; } }
                const float e0 = s0 - g0[7], e1 = s1 - g1[7];
#pragma unroll
                for (int r = 0; r < 8; ++r) { g0[r] += e0; g1[r] += e1; }
                tot0 = __shfl(s0, 56 + dpl); tot1 = __shfl(s1, 56 + dpl);
            } else {
#pragma unroll
                for (int r = 6; r >= 0; --r) { g0[r] += g0[r + 1]; g1[r] += g1[r + 1]; }
                float s0 = g0[0], s1 = g1[0];
#pragma unroll
                for (int o = 8; o < 64; o <<= 1) { const float t0 = __shfl_down(s0, o), t1 = __shfl_down(s1, o); if (lane + o < 64) { s0 += t0; s1 += t1; } }
                const float e0 = s0 - g0[0], e1 = s1 - g1[0];
#pragma unroll
                for (int r = 0; r < 8; ++r) { g0[r] += e0; g1[r] += e1; }
                tot0 = __shfl(s0, dpl); tot1 = __shfl(s1, dpl);
            }
            const float d0 = __expf(tot0), d1 = __expf(tot1);
            unsigned kt0[4], kt1[4];
#pragma unroll
            for (int r = 0; r < 8; r += 2) {
                float qa[2][2], ka[2][2], ta[2][2];
#pragma unroll
                for (int u = 0; u < 2; ++u) { const float eb0 = __expf(g0[r + u]), eb1 = __expf(g1[r + u]); const float ib0 = __builtin_amdgcn_rcpf(eb0), ib1 = __builtin_amdgcn_rcpf(eb1);
                    const float q0 = bflo(qw[r + u]), q1 = bfhi(qw[r + u]), k0 = bflo(kw[r + u]), k1 = bfhi(kw[r + u]);
                    qa[u][0] = q0 * eb0; qa[u][1] = q1 * eb1; ka[u][0] = k0 * ib0; ka[u][1] = k1 * ib1; ta[u][0] = k0 * ib0 * d0; ta[u][1] = k1 * ib1 * d1;
                    const int row = rg * 8 + r + u; const int off = row * 256 + ((((p0 >> 3) ^ (row & 15)) << 4) | ((p0 & 7) << 1));
                    *(LAS unsigned*)(lds + PP_QD + dir * 16384 + off) = pkbf(qa[u][0], qa[u][1]);
                    *(LAS unsigned*)(lds + PP_KD + dir * 16384 + off) = pkbf(ka[u][0], ka[u][1]); }
                kt0[r >> 1] = pkbf(ta[0][0], ta[1][0]); kt1[r >> 1] = pkbf(ta[0][1], ta[1][1]);
            }
            unsigned char* pd = P.ws + GL_PD + ((size_t)dir * 2560 + task) * GL_PD_BYTES;
            { const int dA = c0, dB = c0 + 1;
              *(u32x4*)(pd + 24576 + dA * 128 + ((rg ^ ((dA >> 1) & 7)) << 4)) = (u32x4){kt0[0], kt0[1], kt0[2], kt0[3]};
              *(u32x4*)(pd + 24576 + dB * 128 + ((rg ^ ((dB >> 1) & 7)) << 4)) = (u32x4){kt1[0], kt1[1], kt1[2], kt1[3]}; }
            if (rg == 0) { float* dec = (float*)(P.ws + GL_DEC) + ((size_t)dir * 2560 + task) * 128; *(f32x2*)(dec + c0) = (f32x2){d0, d1}; }
        }
        __syncthreads();
        { const int dir = wid >> 2, ti = (wid >> 1) & 1, tj = wid & 1; const int i = ti * 32 + r32, jr = tj * 32 + r32;
          f32x16 acc; for (int x = 0; x < 16; ++x) acc[x] = 0.f;
#pragma unroll
          for (int s = 0; s < 8; ++s) { const int ch = 2 * s + hi;
              const bf16x8 a = *(const LAS bf16x8*)(lds + PP_KD + dir * 16384 + jr * 256 + ((ch ^ (jr & 15)) << 4));
              const bf16x8 b = *(const LAS bf16x8*)(lds + PP_QD + dir * 16384 + i * 256 + ((ch ^ (i & 15)) << 4));
              acc = __builtin_amdgcn_mfma_f32_32x32x16_bf16(a, b, acc, 0, 0, 0); }
          unsigned char* am = P.ws + GL_PD + ((size_t)dir * 2560 + task) * GL_PD_BYTES + 16384;
#pragma unroll
          for (int a4 = 0; a4 < 4; ++a4) { float v[4];
#pragma unroll
              for (int b4 = 0; b4 < 4; ++b4) { const int j = tj * 32 + 8 * a4 + 4 * hi + b4; const bool keep = dir ? (j >= i) : (j <= i); v[b4] = keep ? acc[a4 * 4 + b4] : 0.f; }
              u32x2 w; w.x = pkbf(v[0], v[1]); w.y = pkbf(v[2], v[3]);
              *(u32x2*)(am + i * 128 + ((((4 * tj + a4) ^ ((i >> 1) & 7)) << 4) | (hi << 3))) = w; } }
#pragma unroll
        for (int q = 0; q < 4; ++q) { const int e = q * 512 + tid, dir = e >> 10, o = (e & 1023) * 16;
            *(u32x4*)(P.ws + GL_PD + ((size_t)dir * 2560 + task) * GL_PD_BYTES + o) = *(const LAS u32x4*)(lds + PP_QD + dir * 16384 + o); }
#pragma unroll
        for (int q = 0; q < 4; ++q) { const int e = q * 512 + tid, v = e & 255, jo = e >> 8; unsigned short t[8];
#pragma unroll
            for (int x = 0; x < 8; ++x) t[x] = *(const LAS unsigned short*)(lds + PP_V + (jo * 8 + x) * 512 + v * 2);
            u32x4 w; w.x = t[0] | ((unsigned)t[1] << 16); w.y = t[2] | ((unsigned)t[3] << 16); w.z = t[4] | ((unsigned)t[5] << 16); w.w = t[6] | ((unsigned)t[7] << 16);
            *(u32x4*)(P.ws + GL_VT + (size_t)task * 32768 + v * 128 + ((jo ^ ((v >> 1) & 7)) << 4)) = w; }
    }
}

constexpr int CH_BUF = 74752, CH_QD = 0, CH_AM = 16384, CH_KT = 24576, CH_VT = 40960, CH_DEC = 73728;
DI void phase_gla_chain(const Params& P, int l, int task0, int ntask_stride, LAS unsigned char* lds) {
    const int tid = threadIdx.x, wid = __builtin_amdgcn_readfirstlane(tid >> 6), lane = tid & 63, r32 = lane & 31, hi = lane >> 5;
    bf16_t* OFB = (bf16_t*)(P.ws + WS_OFB);
    for (int task = task0; task < NSEQ * 4 * 2; task += ntask_stride) {
        const int dir = task & 1, h = (task >> 1) & 3, sq = task >> 3;
        f32x16 T[4]; for (int d = 0; d < 4; ++d) for (int x = 0; x < 16; ++x) T[d][x] = 0.f;
#define CH_ISSUE(n_, b_) do { const int cs_ = dir ? 63 - (n_) : (n_); const int ct_ = (sq * 64 + cs_) * 4 + h; \
        const unsigned char* pd_ = P.ws + GL_PD + ((size_t)dir * 2560 + ct_) * GL_PD_BYTES; const unsigned char* vt_ = P.ws + GL_VT + (size_t)ct_ * 32768; \
        _Pragma("unroll") for (int q_ = 0; q_ < 9; ++q_) { const int pc_ = wid * 9 + q_; const unsigned char* src_ = (pc_ < 40 ? pd_ + pc_ * 1024 : vt_ + (pc_ - 40) * 1024) + lane * 16; \
            __builtin_amdgcn_global_load_lds((const unsigned*)src_, (LAS unsigned*)(lds + (b_) * CH_BUF + pc_ * 1024), 16, 0, 0); } \
        if (wid < 2) { const float* dc_ = (const float*)(P.ws + GL_DEC) + ((size_t)dir * 2560 + ct_) * 128 + wid * 64 + lane; \
            __builtin_amdgcn_global_load_lds((const unsigned*)dc_, (LAS unsigned*)(lds + (b_) * CH_BUF + CH_DEC + wid * 256), 4, 0, 0); } } while (0)
        __syncthreads();
        CH_ISSUE(0, 0);
        for (int n = 0; n < 64; ++n) {
            const int b = n & 1;
            if (n == 0) asm volatile("s_waitcnt vmcnt(0)" ::: "memory"); else asm volatile("s_waitcnt vmcnt(16)" ::: "memory");
            __builtin_amdgcn_s_barrier();
            asm volatile("" ::: "memory");
            if (n + 1 < 64) CH_ISSUE(n + 1, b ^ 1);
            const LAS unsigned char* B = lds + b * CH_BUF;
            const int i0 = r32, i1 = 32 + r32; const int vv = wid * 32 + r32;
            bf16x8 fa[8], fb[8], vf[4];
            f32x16 o[2]; for (int x = 0; x < 16; ++x) { o[0][x] = 0.f; o[1][x] = 0.f; }
#define RD_QD(dst, s0) _Pragma("unroll") for (int s_ = 0; s_ < 4; ++s_) { dst[s_] = *(const LAS bf16x8*)(B + CH_QD + i0 * 256 + (((2 * ((s0) + s_) + hi) ^ (i0 & 15)) << 4)); \
                dst[4 + s_] = *(const LAS bf16x8*)(B + CH_QD + i1 * 256 + (((2 * ((s0) + s_) + hi) ^ (i1 & 15)) << 4)); }
#define RD_KT(dst, db0) _Pragma("unroll") for (int q_ = 0; q_ < 2; ++q_) { const int d_ = ((db0) + q_) * 32 + r32; \
                _Pragma("unroll") for (int ks_ = 0; ks_ < 4; ++ks_) dst[q_ * 4 + ks_] = *(const LAS bf16x8*)(B + CH_KT + d_ * 128 + (((2 * ks_ + hi) ^ ((d_ >> 1) & 7)) << 4)); }
#define DECAY(db_) do { f32x4 dc_[4]; _Pragma("unroll") for (int a4_ = 0; a4_ < 4; ++a4_) dc_[a4_] = *(const LAS f32x4*)(B + CH_DEC + ((db_) * 32 + 8 * a4_ + 4 * hi) * 4); \
                _Pragma("unroll") for (int a4_ = 0; a4_ < 4; ++a4_) _Pragma("unroll") for (int b4_ = 0; b4_ < 4; ++b4_) T[db_][a4_ * 4 + b4_] *= dc_[a4_][b4_]; } while (0)
#define MM_QD(src, s0) _Pragma("unroll") for (int s_ = 0; s_ < 4; ++s_) { const int db_ = ((s0) + s_) >> 1, o8_ = (((s0) + s_) & 1) * 8; \
                u32x4 w_ = {pkbf(T[db_][o8_ + 0], T[db_][o8_ + 1]), pkbf(T[db_][o8_ + 2], T[db_][o8_ + 3]), pkbf(T[db_][o8_ + 4], T[db_][o8_ + 5]), pkbf(T[db_][o8_ + 6], T[db_][o8_ + 7])}; \
                const bf16x8 sf_ = __builtin_bit_cast(bf16x8, w_); \
                o[0] = __builtin_amdgcn_mfma_f32_32x32x16_bf16(src[s_], sf_, o[0], 0, 0, 0); o[1] = __builtin_amdgcn_mfma_f32_32x32x16_bf16(src[4 + s_], sf_, o[1], 0, 0, 0); }
#define MM_KT(src, db0) _Pragma("unroll") for (int q_ = 0; q_ < 2; ++q_) { \
                _Pragma("unroll") for (int ks_ = 0; ks_ < 4; ++ks_) T[(db0) + q_] = __builtin_amdgcn_mfma_f32_32x32x16_bf16(src[q_ * 4 + ks_], vf[ks_], T[(db0) + q_], 0, 0, 0); }
            RD_QD(fa, 0);
#pragma unroll
            for (int ks = 0; ks < 4; ++ks) vf[ks] = *(const LAS bf16x8*)(B + CH_VT + vv * 128 + (((2 * ks + hi) ^ ((vv >> 1) & 7)) << 4));
            __builtin_amdgcn_sched_barrier(0);
            RD_QD(fb, 4);
            __builtin_amdgcn_sched_barrier(0);
            MM_QD(fa, 0);
            DECAY(0); DECAY(1);
            __builtin_amdgcn_sched_barrier(0);
#pragma unroll
            for (int ks = 0; ks < 4; ++ks) { fa[ks] = *(const LAS bf16x8*)(B + CH_AM + i0 * 128 + (((2 * ks + hi) ^ ((i0 >> 1) & 7)) << 4)); fa[4 + ks] = *(const LAS bf16x8*)(B + CH_AM + i1 * 128 + (((2 * ks + hi) ^ ((i1 >> 1) & 7)) << 4)); }
            __builtin_amdgcn_sched_barrier(0);
            MM_QD(fb, 4);
            DECAY(2); DECAY(3);
            __builtin_amdgcn_sched_barrier(0);
            RD_KT(fb, 0);
            __builtin_amdgcn_sched_barrier(0);
#pragma unroll
            for (int ks = 0; ks < 4; ++ks) { o[0] = __builtin_amdgcn_mfma_f32_32x32x16_bf16(fa[ks], vf[ks], o[0], 0, 0, 0); o[1] = __builtin_amdgcn_mfma_f32_32x32x16_bf16(fa[4 + ks], vf[ks], o[1], 0, 0, 0); }
            __builtin_amdgcn_sched_barrier(0);
            RD_KT(fa, 2);
            __builtin_amdgcn_sched_barrier(0);
            MM_KT(fb, 0);
            __builtin_amdgcn_sched_barrier(0);
            MM_KT(fa, 2);
#undef RD_QD
#undef RD_KT
#undef MM_QD
#undef MM_KT
#undef DECAY
            { const int cs = dir ? 63 - n : n; const size_t tokb = (size_t)sq * SEQL + cs * 64; const int odd = lane & 1;
              bf16_t* ob = OFB + (size_t)dir * MTOK * 1024 + h * 256 + wid * 32 + (r32 & ~1);
#pragma unroll
              for (int ib = 0; ib < 2; ++ib)
#pragma unroll
                  for (int x = 0; x < 16; x += 2) { float ea_ = o[ib][x], eb_ = o[ib][x + 1]; asm volatile("" : "+v"(ea_), "+v"(eb_)); const float mine = odd ? eb_ : ea_, give = odd ? ea_ : eb_;
                      const float got = __int_as_float(__builtin_amdgcn_update_dpp(0, __float_as_int(give), 0xB1, 0xF, 0xF, true));
                      const unsigned w = odd ? pkbf(got, mine) : pkbf(mine, got);
                      *(unsigned*)(ob + (tokb + ib * 32 + crow(x + odd, hi)) * 1024) = w; } }
        }
#undef CH_ISSUE
    }
}


#define XB_TMO      128
#define XB_XCNT(j)  (256  + 64 * (j))
#define XB_XSUB(j)  (1280 + 64 * (j))
#define XB_XGEN(j)  (2304 + 64 * (j))
#define XB_TOP      3328
#define XB_TOPGEN   3392
#define XCD_BAR_WORDS 3456
#define XB_SPIN_CAP (1u << 18)

__device__ __forceinline__ unsigned xb_ld(unsigned* p)              { return __hip_atomic_load(p, __ATOMIC_RELAXED, __HIP_MEMORY_SCOPE_AGENT); }
__device__ __forceinline__ unsigned xb_add(unsigned* p, unsigned v) { return __hip_atomic_fetch_add(p, v, __ATOMIC_RELAXED, __HIP_MEMORY_SCOPE_AGENT); }
__device__ __forceinline__ unsigned xb_xcc_id() { return (unsigned)__builtin_amdgcn_s_getreg((3 << 11) | 20) & 0xFu; }
#define XB_SPIN(cond, bar) do { unsigned _sp = 0; while (cond) { __builtin_amdgcn_s_sleep(1); \
    if ((++_sp & 255u) == 0u) { if (xb_ld(&(bar)[XB_TMO])) break; if (_sp > XB_SPIN_CAP) { atomicAdd(&(bar)[XB_TMO], 1u); break; } } } } while (0)

struct XcdBarrier {
    unsigned* bar; unsigned x;
    volatile LAS unsigned* st;
};

__device__ __forceinline__ XcdBarrier xcd_barrier_post(unsigned* bar, volatile LAS unsigned* st) {
    XcdBarrier b; b.bar = bar; b.x = xb_xcc_id(); b.st = st;
    if (threadIdx.x == 0) (void)xb_add(&bar[XB_XCNT(b.x)], 1u);
    return b;
}
__device__ __forceinline__ void xcd_barrier_complete(unsigned* bar, unsigned x, unsigned& nloc, unsigned& nx) {
    const unsigned G = gridDim.x * gridDim.y * gridDim.z;
    unsigned sum, cnt, mine, sp = 0u;
    for (;;) {
        sum = 0u; cnt = 0u; mine = 0u;
#pragma unroll
        for (unsigned j = 0; j < 16; ++j) { const unsigned c = xb_ld(&bar[XB_XCNT(j)]); sum += c; cnt += (c > 0u) ? 1u : 0u; mine = (j == x) ? c : mine; }
        if (sum == G) break;
        __builtin_amdgcn_s_sleep(1);
        if ((++sp & 255u) == 0u) { if (xb_ld(&bar[XB_TMO])) break; if (sp > XB_SPIN_CAP) { atomicAdd(&bar[XB_TMO], 1u); break; } }
    }
    nloc = mine > 0u ? mine : 1u; nx = cnt > 0u ? cnt : 1u;
}

__device__ __forceinline__ void xcd_barrier(const XcdBarrier& b) {
    asm volatile("s_waitcnt vmcnt(0)" ::: "memory");
    __syncthreads();
    if (threadIdx.x == 0) {
        unsigned* bar = b.bar;
        __builtin_amdgcn_s_waitcnt(0);
        unsigned nloc = b.st[0], nx = b.st[1];
        if (nloc == 0u) { xcd_barrier_complete(bar, b.x, nloc, nx); b.st[0] = nloc; b.st[1] = nx; }
        const unsigned old = xb_add(&bar[XB_XSUB(b.x)], 1u);
        const unsigned gen = old / nloc;
        if (old + 1u == (gen + 1u) * nloc) {
            __builtin_amdgcn_fence(__ATOMIC_RELEASE, "agent");
            asm volatile("s_waitcnt vmcnt(0)" ::: "memory");
            const unsigned og = xb_add(&bar[XB_TOP], 1u);
            const unsigned tg = og / nx;
            if (og + 1u == (tg + 1u) * nx) xb_add(&bar[XB_TOPGEN], 1u);
            else XB_SPIN(xb_ld(&bar[XB_TOPGEN]) == tg, bar);
            __builtin_amdgcn_fence(__ATOMIC_ACQUIRE, "agent");
            xb_add(&bar[XB_XGEN(b.x)], 1u);
            asm volatile("s_waitcnt vmcnt(0)" ::: "memory");
        } else {
            XB_SPIN(xb_ld(&bar[XB_XGEN(b.x)]) == gen, bar);
            __builtin_amdgcn_fence(__ATOMIC_ACQUIRE, "agent");
            asm volatile("s_waitcnt vmcnt(0)" ::: "memory");
        }
    }
    __syncthreads();
}


constexpr int N_PHASES = 13;
#ifndef REP_GEMM
#define REP_GEMM 1
#endif
#ifndef REP_MEM
#define REP_MEM 1
#endif
#ifndef REP_P2
#define REP_P2 1
#endif
__global__ void __launch_bounds__(NTHR, 2) hymba_fwd(Params P) {
    extern __shared__ __attribute__((aligned(16))) unsigned char lds_raw[];
    LAS unsigned char* lds = (LAS unsigned char*)lds_raw;
    const int bid = blockIdx.x, nb = gridDim.x;
    const int lo = P.ph_lo, hi = P.ph_hi;
    XcdBarrier xb; xb.bar = (unsigned*)(P.ws + WS_CTL); xb.x = 0; xb.st = (volatile LAS unsigned*)(lds + LDS_BARW);
#if MK_ONE_LAUNCH
#define SEAM(k) do { if ((k) + 1 < hi) { if ((k) == 0) { cg::this_grid().sync(); if (threadIdx.x < 4) ((volatile LAS unsigned*)(lds + LDS_BARW))[threadIdx.x] = 0u; __syncthreads(); \
        xb = xcd_barrier_post((unsigned*)(P.ws + WS_CTL), (volatile LAS unsigned*)(lds + LDS_BARW)); } else xcd_barrier(xb); } } while (0)
#else
#define SEAM(k) do { } while (0)
#endif
#define IN(k) (lo <= (k) && (k) < hi)
    if (IN(0)) { phase_prep(P, bid, nb, lds); SEAM(0); }
#define LAYER(l, b0) \
    if (IN(b0 + 0)) { _Pragma("unroll 1") for (int rep = 0; rep < REP_GEMM; ++rep) { phase_gates(P, l, bid, nb, lds); phase_inproj(P, l, bid, nb, lds); } SEAM(b0 + 0); } \
    if (IN(b0 + 1)) { _Pragma("unroll 1") for (int rep = 0; rep < REP_MEM; ++rep) phase_gla_prep(P, l, bid, nb, lds); SEAM(b0 + 1); } \
    if (IN(b0 + 2)) { _Pragma("unroll 1") for (int rep = 0; rep < REP_P2; ++rep) { if (bid < 80) phase_gla_chain(P, l, bid, 80, lds); phase_attn(P, l, lds); } SEAM(b0 + 2); } \
    if (IN(b0 + 3)) { _Pragma("unroll 1") for (int rep = 0; rep < REP_MEM; ++rep) phase_fixup(P, l, bid, nb); SEAM(b0 + 3); } \
    if (IN(b0 + 4)) { _Pragma("unroll 1") for (int rep = 0; rep < REP_GEMM; ++rep) phase_outproj(P, l, bid, nb, lds); SEAM(b0 + 4); } \
    if (IN(b0 + 5)) { phase_post(P, l, bid, nb); SEAM(b0 + 5); }
    LAYER(0, 1)
    LAYER(1, 7)
#undef LAYER
#undef IN
#undef SEAM
}

extern "C" void kernel_launch(void* const* d_in, const int* in_sizes, int n_in, void* d_out, int out_size, void* d_ws, size_t ws_size, hipStream_t stream) {
    static int grid = 0;
    if (grid == 0) {
        if (n_in != 13 || out_size != MTOK * DM || ws_size < WS_END) { fprintf(stderr, "kernel_launch: unexpected shapes (n_in %d out %d ws %zu need %zu)\n", n_in, out_size, ws_size, (size_t)WS_END); grid = -1; return; }
        int dev = 0, cus = 0, per_cu = 0;
        hipGetDevice(&dev); hipDeviceGetAttribute(&cus, hipDeviceAttributeMultiprocessorCount, dev);
        if (hipFuncSetAttribute((const void*)hymba_fwd, hipFuncAttributeMaxDynamicSharedMemorySize, LDS_BYTES) != hipSuccess) { fprintf(stderr, "kernel_launch: hipFuncSetAttribute failed\n"); grid = -1; return; }
        if (hipOccupancyMaxActiveBlocksPerMultiprocessor(&per_cu, (const void*)hymba_fwd, NTHR, LDS_BYTES) != hipSuccess || per_cu < 1) { fprintf(stderr, "kernel_launch: occupancy query gave %d\n", per_cu); per_cu = 1; }
        (void)hipGetLastError();
        grid = cus * 1;
        fprintf(stderr, "kernel_launch: cus %d per_cu %d grid %d\n", cus, per_cu, grid);
    }
    if (grid < 0) return;
    Params p{};
    p.x_prompt = (const float*)d_in[0]; p.x_sample = (const float*)d_in[1]; p.rel_bias = (const float*)d_in[2]; p.w_in = (const float*)d_in[3];
    p.w_gk_f = (const float*)d_in[4]; p.b_gk_f = (const float*)d_in[5]; p.w_gk_b = (const float*)d_in[6]; p.b_gk_b = (const float*)d_in[7];
    p.sink = (const float*)d_in[8]; p.gla_norm = (const float*)d_in[9]; p.w_out = (const float*)d_in[10]; p.norm_pre = (const float*)d_in[11]; p.norm_post = (const float*)d_in[12];
    p.out = (float*)d_out; p.ws = (unsigned char*)d_ws;
#if MK_ONE_LAUNCH
    p.ph_lo = 0; p.ph_hi = N_PHASES;
    void* args[] = {&p};
    hipError_t e = hipLaunchCooperativeKernel((const void*)hymba_fwd, dim3(grid), dim3(NTHR), args, LDS_BYTES, stream);
    if (e != hipSuccess) fprintf(stderr, "kernel_launch: cooperative launch failed: %s (grid %d)\n", hipGetErrorString(e), grid);
#else
    for (int ph = 0; ph < N_PHASES; ++ph) { p.ph_lo = ph; p.ph_hi = ph + 1; hipLaunchKernelGGL(hymba_fwd, dim3(grid), dim3(NTHR), LDS_BYTES, stream, p); }
#endif
}
```

```cpp
#include <hip/hip_runtime.h>
#include <hip/hip_cooperative_groups.h>
#include <cstdio>
#include <cstdint>
namespace cg = cooperative_groups;

#ifndef MK_ONE_LAUNCH
#define MK_ONE_LAUNCH 1
#endif

constexpr int MTOK = 40960, DM = 2048, SEQL = 4096, NSEQ = 10, NPROMPT = 32768;
constexpr int NIN = 5664, NMAIN = 5632;
constexpr int NTHR = 512;
constexpr float LOG2E = 1.4426950408889634f;
constexpr float QSCALE_A = 0.08838834764831845f * 1.4426950408889634f;
constexpr float QSCALE_B = 0.08838834764831845f;
constexpr float EPS = 1e-6f;
constexpr int LDS_BYTES = 155904;
constexpr int LDS_BARW = 155648;

constexpr size_t WS_WIN  = 0;
constexpr size_t WS_WOUT = WS_WIN + (size_t)2 * NIN * DM * 2;
constexpr size_t WS_PA   = WS_WOUT + (size_t)2 * DM * DM * 2;
constexpr size_t WS_PG   = WS_PA + (size_t)MTOK * 2560 * 2;
constexpr size_t WS_PZ   = WS_PG + (size_t)MTOK * 2048 * 2;
constexpr size_t WS_LR   = WS_PZ + (size_t)MTOK * 1024 * 2;
constexpr size_t WS_XB   = WS_LR + (size_t)MTOK * 32 * 4;
constexpr size_t WS_SSQ  = WS_XB + (size_t)MTOK * DM * 2;
constexpr size_t WS_RSTD = WS_SSQ + (size_t)MTOK * 32 * 4;
constexpr size_t WS_TAB  = WS_RSTD + (size_t)MTOK * 4;
constexpr size_t WS_CTL  = WS_TAB + 16384;
constexpr size_t WS_GLA  = WS_CTL + 16384;
constexpr size_t WS_MIXOUT = WS_PG;
constexpr size_t GL_PD_BYTES = 40960;
constexpr size_t GL_PD  = WS_GLA;
constexpr size_t GL_VT  = GL_PD + (size_t)2 * 2560 * GL_PD_BYTES;
constexpr size_t GL_DEC = GL_VT + (size_t)2560 * 32768;
constexpr size_t GL_END = GL_DEC + (size_t)2 * 2560 * 512;
constexpr size_t WS_OFB = WS_PG;
constexpr size_t WS_KB = GL_END;
constexpr size_t WS_VB = WS_KB + (size_t)2 * MTOK * 128 * 2;
constexpr size_t WS_SSQ0 = WS_VB + (size_t)2 * MTOK * 128 * 2;
constexpr size_t WS_END = WS_SSQ0 + (size_t)MTOK * 32 * 4;

typedef unsigned short bf16_t;
typedef short bf16x8 __attribute__((ext_vector_type(8)));
typedef short s16x4 __attribute__((ext_vector_type(4)));
typedef float f32x4 __attribute__((ext_vector_type(4)));
typedef float f32x16 __attribute__((ext_vector_type(16)));
typedef unsigned u32x4 __attribute__((ext_vector_type(4)));
typedef unsigned u32x2 __attribute__((ext_vector_type(2)));
#define LAS __attribute__((address_space(3)))
#define DI __device__ __forceinline__

DI unsigned cvt_pk_bf16(float lo, float hi) { unsigned r; asm volatile("v_cvt_pk_bf16_f32 %0, %1, %2" : "=v"(r) : "v"(lo), "v"(hi)); return r; }
DI float bf2f(bf16_t b) { return __uint_as_float(((unsigned)b) << 16); }
DI float bflo(unsigned w) { return __uint_as_float(w << 16); }
DI float bfhi(unsigned w) { return __uint_as_float(w & 0xffff0000u); }
DI bf16_t f2bf(float f) { return (bf16_t)(cvt_pk_bf16(f, 0.f) & 0xffffu); }
DI float wave_sum(float v) { for (int o = 32; o >= 1; o >>= 1) v += __shfl_xor(v, o); return v; }
DI float silu(float z) { return z / (1.0f + __expf(-z)); }
DI float logsigmoid(float z) { return fminf(z, 0.f) - log1pf(__expf(-fabsf(z))); }

struct Params {
    const float* x_prompt; const float* x_sample; const float* rel_bias; const float* w_in; const float* w_gk_f; const float* b_gk_f;
    const float* w_gk_b; const float* b_gk_b; const float* sink; const float* gla_norm; const float* w_out; const float* norm_pre; const float* norm_post;
    float* out; unsigned char* ws; int ph_lo, ph_hi;
};

namespace pg8 {
#define PG8_LAS __attribute__((address_space(3)))
typedef unsigned short bf16_t;
typedef short bf16x8 __attribute__((ext_vector_type(8)));
typedef float f32x4 __attribute__((ext_vector_type(4)));
typedef unsigned u32x4 __attribute__((ext_vector_type(4)));
constexpr int BM = 256, BK = 64, HALF = 128, HTB = HALF * BK * 2  , STAGE_BYTES = 8 * HTB, NXCD = 8, WGM = 4;

__host__ __device__ __forceinline__ int lds_byte(int r, int c) { const int st = (r >> 4) * 2 + (c >> 5), rr = r & 15, cc = c & 31, ob = rr * 64 + cc * 2; return st * 1024 + (ob ^ (((ob >> 9) & 1) << 5)); }
__host__ __device__ __forceinline__ void stage_rc(int b, int& R, int& C) { const int st = b / 1024, sb = b % 1024, swz = sb ^ (((sb >> 9) & 1) << 5); R = (st >> 1) * 16 + swz / 64; C = (st & 1) * 32 + (swz % 64) / 2; }
__host__ __device__ __forceinline__ int perm32(int rho) { const int n = rho >> 4, i = rho & 15; return 8 * (i >> 2) + 4 * n + (i & 3); }

struct Unit { int pm, pn; };
struct Gemm { const bf16_t* A; const bf16_t* Bt; int M, N, K; };

struct StaticOrder {
    int nM, nN, nwg, G, c;
    __host__ __device__ void init(int M, int N, int G_, int c_) { nM = M / BM; nN = N / BM; nwg = nM * nN; G = G_; c = c_; }
    __host__ __device__ bool next(int i, Unit& u) const {
        const long L = (long)i * G + c; if (L >= nwg) return false;
        int wgid = (int)L; { const int q = nwg / NXCD, r = nwg % NXCD, xcd = wgid % NXCD, off = wgid / NXCD; wgid = (xcd < r ? xcd * (q + 1) : r * (q + 1) + (xcd - r) * q) + off; }
        const int nig = WGM * nN, gid = wgid / nig, fm = gid * WGM, gsz = (nM - fm) < WGM ? (nM - fm) : WGM;
        u.pm = fm + ((wgid % nig) % gsz); u.pn = (wgid % nig) / gsz; return true;
    }
    __device__ __forceinline__ void a_ready(const Unit&) const {}
    __device__ __forceinline__ void done(const Unit&) const {}
};


__device__ __forceinline__ unsigned cvt_pk(float lo, float hi) { unsigned r; asm volatile("v_cvt_pk_bf16_f32 %0, %1, %2" : "=v"(r) : "v"(lo), "v"(hi)); return r; }

struct EpiProj {
    static constexpr bool PERM = true, AFTER_DRAIN = false;
    bf16_t* PA; bf16_t* PG; bf16_t* PZ; const float* rstd; float qsa, qsb; bf16_t* KB; bf16_t* VB;
    __device__ __forceinline__ void operator()(const f32x4 (&acc)[2][2][4][2], const Unit& u, int wr, int wc, int fr, int fq) const {
        const int pn = u.pn; bf16_t* base; int ldc, colt; float sc = 1.f;
        if (pn < 10) { base = PA; ldc = 2560; colt = pn * 256; if (pn < 4) sc = qsa; }
        else if (pn < 18) { base = PG; ldc = 2048; colt = (pn - 10) * 256; if (pn < 12) sc = qsb; }
        else { base = PZ; ldc = 1024; colt = (pn - 18) * 256; }
        const int row0 = u.pm * BM + wr * 64 + fr, col0 = colt + wc * 32 + 8 * fq;
#pragma unroll
        for (int ai = 0; ai < 2; ++ai)
#pragma unroll
            for (int m = 0; m < 4; ++m) { const int row = row0 + ai * HALF + m * 16; const float rs = sc; bf16_t* rowp = base + (size_t)row * ldc + col0;
#pragma unroll
                for (int bj = 0; bj < 2; ++bj) { const f32x4 v0 = acc[ai][bj][m][0] * rs, v1 = acc[ai][bj][m][1] * rs;
                    u32x4 w; w.x = cvt_pk(v0[0], v0[1]); w.y = cvt_pk(v0[2], v0[3]); w.z = cvt_pk(v1[0], v1[1]); w.w = cvt_pk(v1[2], v1[3]);
                    if (pn == 4 || pn == 5) *(u32x4*)((pn == 4 ? KB : VB) + ((size_t)bj * 40960 + row) * 128 + wc * 32 + 8 * fq) = w;
                    else if (pn >= 18) __builtin_nontemporal_store(w, (u32x4*)(rowp + bj * HALF));
                    else *(u32x4*)(rowp + bj * HALF) = w; } }
    }
};
struct EpiOut {
    static constexpr bool PERM = true, AFTER_DRAIN = false;
    bf16_t* O; float* ssq; int ldo;
    __device__ __forceinline__ void operator()(const f32x4 (&acc)[2][2][4][2], const Unit& u, int wr, int wc, int fr, int fq) const {
        const int row0 = u.pm * BM + wr * 64 + fr, col0 = u.pn * BM + wc * 32 + 8 * fq;
#pragma unroll
        for (int ai = 0; ai < 2; ++ai)
#pragma unroll
            for (int m = 0; m < 4; ++m) { const int row = row0 + ai * HALF + m * 16; bf16_t* rowp = O + (size_t)row * ldo + col0; float s = 0.f;
#pragma unroll
                for (int bj = 0; bj < 2; ++bj) { const f32x4 v0 = acc[ai][bj][m][0], v1 = acc[ai][bj][m][1];
                    s += (v0[0] * v0[0] + v0[1] * v0[1]) + (v0[2] * v0[2] + v0[3] * v0[3]) + (v1[0] * v1[0] + v1[1] * v1[1]) + (v1[2] * v1[2] + v1[3] * v1[3]);
                    u32x4 w; w.x = cvt_pk(v0[0], v0[1]); w.y = cvt_pk(v0[2], v0[3]); w.z = cvt_pk(v1[0], v1[1]); w.w = cvt_pk(v1[2], v1[3]);
                    *(u32x4*)(rowp + bj * HALF) = w; }
                s += __shfl_xor(s, 16); s += __shfl_xor(s, 32);
                if (fq == 0) ssq[(size_t)row * 32 + u.pn * 4 + wc] = s; }
    }
};
template <class Epi, class Sched, bool ALIGN_EPI = false, bool SP2 = false>
__device__ __forceinline__ void gemm_phase(PG8_LAS unsigned char* lds, const Gemm g, const Sched& S, const Epi& E) {
    const int tid = threadIdx.x, wid = __builtin_amdgcn_readfirstlane(tid >> 6), lane = tid & 63, wr = wid >> 2, wc = wid & 3, fr = lane & 15, fq = lane >> 4;
    const int K = g.K, nt = K / BK;
    unsigned voffA[2], voffB[2];
#pragma unroll
    for (int i = 0; i < 2; ++i) { int R, C; stage_rc(tid * 16 + i * 8192, R, C); const int Rb = Epi::PERM ? ((R & ~31) + perm32(R & 31)) : R;
        voffA[i] = (unsigned)(R * K + C) * 2u; voffB[i] = (unsigned)(Rb * K + C) * 2u; }
    const size_t kstep = (size_t)(BK * 2);
    const size_t hstep = (size_t)HALF * K * 2;
    const size_t tstep = 2 * hstep;
    const unsigned ldsw = (unsigned)wid * 1024u;
    const int aoff = lds_byte(wr * 64 + fr, fq * 8), boff = lds_byte(wc * 32 + fr, fq * 8);
#define PG8_SA(b, h) (((b) * 2 + (h)) * HTB)
#define PG8_SB(b, h) ((4 + (b) * 2 + (h)) * HTB)
#define PG8_STAGE(bufoff, gbase, voff) do { _Pragma("unroll") for (int _i = 0; _i < 2; ++_i) \
        __builtin_amdgcn_global_load_lds((const unsigned*)((const char*)(gbase) + (voff)[_i]), (PG8_LAS unsigned*)(lds + (bufoff) + ldsw + _i * 8192), 16, 0, 0); } while (0)
#define PG8_LDA(dst, b, h) do { _Pragma("unroll") for (int m = 0; m < 4; ++m) _Pragma("unroll") for (int k = 0; k < 2; ++k) dst[m][k] = *(const PG8_LAS bf16x8*)(lds + PG8_SA(b, h) + aoff + m * 2048 + k * 1024); } while (0)
#define PG8_LDB(dst, b, h) do { _Pragma("unroll") for (int n = 0; n < 2; ++n) _Pragma("unroll") for (int k = 0; k < 2; ++k) dst[n][k] = *(const PG8_LAS bf16x8*)(lds + PG8_SB(b, h) + boff + n * 2048 + k * 1024); } while (0)
#define PG8_MMA(ai, bj, At, Bt) do { __builtin_amdgcn_s_setprio(1); _Pragma("unroll") for (int m = 0; m < 4; ++m) _Pragma("unroll") for (int n = 0; n < 2; ++n) _Pragma("unroll") for (int k = 0; k < 2; ++k) \
        acc[ai][bj][m][n] = __builtin_amdgcn_mfma_f32_16x16x32_bf16(Bt[n][k], At[m][k], acc[ai][bj][m][n], 0, 0, 0); __builtin_amdgcn_s_setprio(0); } while (0)
#define PG8_WAIT_V(n) asm volatile("s_waitcnt vmcnt(" #n ")" ::: "memory")
#define PG8_WAIT_L(n) asm volatile("s_waitcnt lgkmcnt(" #n ")" ::: "memory")
#define PG8_BAR __builtin_amdgcn_s_barrier()
#define PG8_SCHED __builtin_amdgcn_sched_barrier(0)
    Unit cur, nxt; int ui = 0;
    if (!S.next(0, cur)) return;
    f32x4 acc[2][2][4][2];
#pragma unroll
    for (int a = 0; a < 2; ++a)
#pragma unroll
        for (int b = 0; b < 2; ++b)
#pragma unroll
            for (int m = 0; m < 4; ++m)
#pragma unroll
                for (int n = 0; n < 2; ++n) acc[a][b][m][n] = (f32x4){0.f, 0.f, 0.f, 0.f};
    bf16x8 At[4][2], B0[2][2], B1[2][2];
    const char* cA = (const char*)g.A + (size_t)cur.pm * tstep; const char* cB = (const char*)g.Bt + (size_t)cur.pn * tstep;
    S.a_ready(cur);
    if constexpr (SP2) {
        PG8_STAGE(PG8_SB(0, 0), cB, voffB); PG8_STAGE(PG8_SB(0, 1), cB + hstep, voffB); PG8_STAGE(PG8_SA(0, 0), cA, voffA); PG8_STAGE(PG8_SA(0, 1), cA + hstep, voffA);
        if (wr == 1) PG8_BAR;
        PG8_WAIT_V(2); PG8_BAR;
        PG8_STAGE(PG8_SB(1, 0), cB + kstep, voffB); PG8_STAGE(PG8_SA(1, 0), cA + kstep, voffA); PG8_STAGE(PG8_SB(1, 1), cB + hstep + kstep, voffB);
        PG8_WAIT_V(6); PG8_BAR;
    } else {
        PG8_STAGE(PG8_SB(0, 0), cB, voffB); PG8_STAGE(PG8_SA(0, 0), cA, voffA); PG8_STAGE(PG8_SB(0, 1), cB + hstep, voffB); PG8_STAGE(PG8_SA(0, 1), cA + hstep, voffA);
        if (wr == 1) PG8_BAR;
        PG8_WAIT_V(4); PG8_BAR;
        PG8_STAGE(PG8_SB(1, 0), cB + kstep, voffB); PG8_STAGE(PG8_SA(1, 0), cA + kstep, voffA); PG8_STAGE(PG8_SB(1, 1), cB + hstep + kstep, voffB);
        PG8_WAIT_V(6); PG8_BAR;
    }
    for (;;) {
        const bool has_next = S.next(ui + 1, nxt);
        const char* nA = has_next ? (const char*)g.A + (size_t)nxt.pm * tstep : cA; const char* nB = has_next ? (const char*)g.Bt + (size_t)nxt.pn * tstep : cB;
        for (int t = 0; t < nt; t += 2) {
            const bool last = (t == nt - 2);
            const char* a1 = cA + (size_t)(t + 1) * kstep;
            const char* a2 = last ? nA : cA + (size_t)(t + 2) * kstep; const char* b2 = last ? nB : cB + (size_t)(t + 2) * kstep;
            const char* a3 = a2 + kstep; const char* b3 = b2 + kstep;
            if (last && has_next) S.a_ready(nxt);
            if constexpr (SP2) {
            PG8_LDB(B0, 0, 0); PG8_LDB(B1, 0, 1); PG8_SCHED; PG8_LDA(At, 0, 0); PG8_STAGE(PG8_SA(1, 1), a1 + hstep, voffA);
            PG8_WAIT_V(8); PG8_WAIT_L(0); PG8_BAR; PG8_MMA(0, 0, At, B0); PG8_MMA(0, 1, At, B1); PG8_BAR; PG8_SCHED;
            PG8_LDA(At, 0, 1); PG8_STAGE(PG8_SB(0, 0), b2, voffB); PG8_STAGE(PG8_SB(0, 1), b2 + hstep, voffB); PG8_STAGE(PG8_SA(0, 0), a2, voffA);
            PG8_WAIT_V(8); PG8_WAIT_L(0); PG8_BAR; PG8_MMA(1, 0, At, B0); PG8_MMA(1, 1, At, B1); PG8_BAR; PG8_SCHED;
            PG8_LDB(B0, 1, 0); PG8_LDB(B1, 1, 1); PG8_SCHED; PG8_LDA(At, 1, 0); PG8_STAGE(PG8_SA(0, 1), a2 + hstep, voffA);
            PG8_WAIT_V(8); PG8_WAIT_L(0); PG8_BAR; PG8_MMA(0, 0, At, B0); PG8_MMA(0, 1, At, B1); PG8_BAR; PG8_SCHED;
            PG8_LDA(At, 1, 1); PG8_STAGE(PG8_SB(1, 0), b3, voffB); PG8_STAGE(PG8_SB(1, 1), b3 + hstep, voffB); PG8_STAGE(PG8_SA(1, 0), a3, voffA);
            PG8_WAIT_V(8); PG8_WAIT_L(0); PG8_BAR; PG8_MMA(1, 0, At, B0); PG8_MMA(1, 1, At, B1); PG8_BAR; PG8_SCHED;
            } else {
            PG8_LDB(B0, 0, 0); PG8_SCHED; PG8_LDA(At, 0, 0); PG8_STAGE(PG8_SA(1, 1), a1 + hstep, voffA);
            PG8_WAIT_L(8); PG8_BAR; PG8_WAIT_L(0); PG8_MMA(0, 0, At, B0); PG8_BAR; PG8_SCHED;
            PG8_LDB(B1, 0, 1); PG8_STAGE(PG8_SB(0, 0), b2, voffB);
            PG8_BAR; PG8_WAIT_L(0); PG8_MMA(0, 1, At, B1); PG8_BAR;
            PG8_LDA(At, 0, 1); PG8_STAGE(PG8_SA(0, 0), a2, voffA);
            PG8_BAR; PG8_WAIT_L(0); PG8_MMA(1, 0, At, B0); PG8_BAR; PG8_SCHED;
            PG8_STAGE(PG8_SB(0, 1), b2 + hstep, voffB);
            PG8_WAIT_V(6); PG8_BAR; PG8_MMA(1, 1, At, B1); PG8_BAR;
            PG8_LDB(B0, 1, 0); PG8_SCHED; PG8_LDA(At, 1, 0); PG8_STAGE(PG8_SA(0, 1), a2 + hstep, voffA);
            PG8_WAIT_L(8); PG8_BAR; PG8_WAIT_L(0); PG8_MMA(0, 0, At, B0); PG8_BAR; PG8_SCHED;
            PG8_LDB(B1, 1, 1); PG8_STAGE(PG8_SB(1, 0), b3, voffB);
            PG8_BAR; PG8_WAIT_L(0); PG8_MMA(0, 1, At, B1); PG8_BAR;
            PG8_LDA(At, 1, 1); PG8_STAGE(PG8_SA(1, 0), a3, voffA);
            PG8_BAR; PG8_WAIT_L(0); PG8_MMA(1, 0, At, B0); PG8_BAR; PG8_SCHED;
            PG8_STAGE(PG8_SB(1, 1), b3 + hstep, voffB);
            PG8_WAIT_V(6); PG8_BAR; PG8_MMA(1, 1, At, B1); PG8_BAR;
            }
        }
        if constexpr (ALIGN_EPI) { if (wr == 0) PG8_BAR; }
        if constexpr (!Epi::AFTER_DRAIN) { E(acc, cur, wr, wc, fr, fq); S.done(cur); }
        if (!has_next) break;
#pragma unroll
        for (int a = 0; a < 2; ++a)
#pragma unroll
            for (int b = 0; b < 2; ++b)
#pragma unroll
                for (int m = 0; m < 4; ++m)
#pragma unroll
                    for (int n = 0; n < 2; ++n) acc[a][b][m][n] = (f32x4){0.f, 0.f, 0.f, 0.f};
        cur = nxt; cA = nA; cB = nB; ++ui;
        if constexpr (ALIGN_EPI) { if (wr == 1) PG8_BAR; }
    }
    PG8_WAIT_V(0);
    if constexpr (!ALIGN_EPI) { if (wr == 0) PG8_BAR; }
    PG8_BAR;
    if constexpr (Epi::AFTER_DRAIN) { E.fused(acc, cur, wr, wc, fr, fq, lds, wid, lane); S.done(cur); }
#undef PG8_SA
#undef PG8_SB
#undef PG8_STAGE
#undef PG8_LDA
#undef PG8_LDB
#undef PG8_MMA
#undef PG8_WAIT_V
#undef PG8_WAIT_L
#undef PG8_BAR
#undef PG8_SCHED
}
}


DI void transpose_w(const float* __restrict__ w, const float* __restrict__ rowscale, bf16_t* __restrict__ out, int K, int N, int bid, int nb, LAS float* tile) {
    const int tid = threadIdx.x, nkt = K / 64, nnt = N / 32, ntile = nkt * nnt;
    for (int t0 = bid; t0 < ntile; t0 += 8 * nb) {
        __syncthreads();
        float v[8][4];
#pragma unroll
        for (int q = 0; q < 8; ++q) { const int t = t0 + q * nb; if (t < ntile) { const int k0 = (t % nkt) * 64, n0 = (t / nkt) * 32;
#pragma unroll
            for (int it = 0; it < 4; ++it) { const int i = it * 16 + (tid >> 5), j = tid & 31; v[q][it] = w[(size_t)(k0 + i) * N + n0 + j]; if (rowscale) v[q][it] *= rowscale[k0 + i]; } } }
#pragma unroll
        for (int q = 0; q < 8; ++q) { const int t = t0 + q * nb; if (t < ntile) {
#pragma unroll
            for (int it = 0; it < 4; ++it) { const int i = it * 16 + (tid >> 5), j = tid & 31; tile[q * 2080 + j * 65 + i] = v[q][it]; } } }
        __syncthreads();
#pragma unroll
        for (int q = 0; q < 8; ++q) { const int t = t0 + q * nb; if (t < ntile) { const int k0 = (t % nkt) * 64, n0 = (t / nkt) * 32;
            const int j = tid >> 4, ii = (tid & 15) * 4; const LAS float* tp = tile + q * 2080 + j * 65 + ii;
            u32x2 o; o.x = cvt_pk_bf16(tp[0], tp[1]); o.y = cvt_pk_bf16(tp[2], tp[3]);
            *(u32x2*)(out + (size_t)(n0 + j) * K + k0 + ii) = o; } }
    }
}
DI const float* x_row(const Params& P, int row) { return row < NPROMPT ? P.x_prompt + (size_t)row * DM : P.x_sample + (size_t)(row - NPROMPT) * DM; }

DI void phase_prep(const Params& P, int bid, int nb, LAS unsigned char* lds) {
    LAS float* tile = (LAS float*)lds;
    for (int l = 0; l < 2; ++l) {
        transpose_w(P.w_in + (size_t)l * DM * NIN, P.norm_pre + l * DM, (bf16_t*)(P.ws + WS_WIN) + (size_t)l * NIN * DM, DM, NIN, bid, nb, tile);
        transpose_w(P.w_out + (size_t)l * DM * DM, nullptr, (bf16_t*)(P.ws + WS_WOUT) + (size_t)l * DM * DM, DM, DM, bid, nb, tile);
    }
    const int wid = threadIdx.x >> 6, lane = threadIdx.x & 63;
    bf16_t* XB = (bf16_t*)(P.ws + WS_XB); float* RSTD = (float*)(P.ws + WS_RSTD);
    for (int row0 = (bid * 8 + wid) * 2; row0 < MTOK; row0 += nb * 16) {
        f32x4 v[2][8];
#pragma unroll
        for (int u = 0; u < 2; ++u) { const float* xr = x_row(P, row0 + u);
#pragma unroll
            for (int it = 0; it < 8; ++it) v[u][it] = __builtin_nontemporal_load((const f32x4*)(xr + (it * 64 + lane) * 4)); }
#pragma unroll
        for (int u = 0; u < 2; ++u) { const int row = row0 + u; float ss = 0.f;
#pragma unroll
            for (int it = 0; it < 8; ++it) { const f32x4 t = v[u][it]; ss += (t[0] * t[0] + t[1] * t[1]) + (t[2] * t[2] + t[3] * t[3]); }
            const float rs = rsqrtf(wave_sum(ss) * (1.0f / DM) + EPS);
#pragma unroll
            for (int it = 0; it < 8; ++it) { const int c = (it * 64 + lane) * 4; const f32x4 t = v[u][it] * rs;
                u32x2 o; o.x = cvt_pk_bf16(t[0], t[1]); o.y = cvt_pk_bf16(t[2], t[3]); *(u32x2*)(XB + (size_t)row * DM + c) = o; } }
    }
    if (bid == 0) { unsigned* bw = (unsigned*)(P.ws + WS_CTL); for (int i = threadIdx.x; i < 4096; i += NTHR) bw[i] = 0u; }
    if (bid == 0) {
        float* tab = (float*)(P.ws + WS_TAB);
        for (int i = threadIdx.x; i < 8 * 257; i += NTHR) { const int h = i / 257, rel = i % 257 - 128, n = rel < 0 ? -rel : rel;
            const int bk = n < 8 ? n : 8 + (n >= 12) + (n >= 16) + (n >= 23) + (n >= 32) + (n >= 46) + (n >= 64) + (n >= 91);
            tab[i] = P.rel_bias[((rel > 0 ? 16 : 0) + bk) * 8 + h] * LOG2E; }
    }
}

DI void phase_gates(const Params& P, int l, int bid, int nb, LAS unsigned char* lds) {
    const int wid = threadIdx.x >> 6, lane = threadIdx.x & 63, r = lane & 31, h = lane >> 5;
    const bf16_t* XB = (const bf16_t*)(P.ws + WS_XB); const bf16_t* Wg = (const bf16_t*)(P.ws + WS_WIN) + ((size_t)l * NIN + NMAIN) * DM;
    float* LR = (float*)(P.ws + WS_LR);
    __syncthreads();
#pragma unroll 4
    for (int q = 0; q < 16; ++q) { const int e = q * 512 + threadIdx.x, n = e >> 8, c16 = e & 255;
        *(LAS u32x4*)(lds + n * 4112 + c16 * 16) = *(const u32x4*)(Wg + (size_t)n * DM + c16 * 8); }
    __syncthreads();
    const LAS unsigned char* bp = lds + r * 4112 + 64 * h;
    for (int t = bid * 8 + wid; t < MTOK / 32; t += nb * 8) {
        const bf16_t* ap = XB + (size_t)(t * 32 + r) * DM + 32 * h;
        f32x16 acc; for (int i = 0; i < 16; ++i) acc[i] = 0.f;
        bf16x8 a[8], an[8];
#pragma unroll
        for (int j = 0; j < 8; ++j) a[j] = *(const bf16x8*)(ap + (j >> 2) * 64 + 8 * (j & 3));
#pragma unroll 1
        for (int kb = 0; kb < DM; kb += 128) {
            if (kb + 128 < DM) {
#pragma unroll
                for (int j = 0; j < 8; ++j) an[j] = *(const bf16x8*)(ap + kb + 128 + (j >> 2) * 64 + 8 * (j & 3)); }
#pragma unroll
            for (int j = 0; j < 8; ++j) { const bf16x8 bj = *(const LAS bf16x8*)(bp + (kb + (j >> 2) * 64 + 8 * (j & 3)) * 2);
                acc = __builtin_amdgcn_mfma_f32_32x32x16_bf16(a[j], bj, acc, 0, 0, 0); }
#pragma unroll
            for (int j = 0; j < 8; ++j) a[j] = an[j];
        }
#pragma unroll
        for (int i = 0; i < 16; ++i) { const int row = t * 32 + (i & 3) + 8 * (i >> 2) + 4 * h; LR[(size_t)row * 32 + r] = acc[i]; }
    }
    __syncthreads();
}

DI void phase_inproj(const Params& P, int l, int bid, int nb, LAS unsigned char* lds) {
    pg8::Gemm g{(const bf16_t*)(P.ws + WS_XB), (const bf16_t*)(P.ws + WS_WIN) + (size_t)l * NIN * DM, MTOK, NMAIN, DM};
    pg8::StaticOrder S; S.init(MTOK, NMAIN, nb, bid);
    pg8::EpiProj E{(bf16_t*)(P.ws + WS_PA), (bf16_t*)(P.ws + WS_PG), (bf16_t*)(P.ws + WS_PZ), (const float*)(P.ws + WS_RSTD), QSCALE_A, QSCALE_B, (bf16_t*)(P.ws + WS_KB), (bf16_t*)(P.ws + WS_VB)};
    pg8::gemm_phase<pg8::EpiProj, pg8::StaticOrder, true, true>(lds, g, S, E);
}
DI void phase_outproj(const Params& P, int l, int bid, int nb, LAS unsigned char* lds) {
    pg8::Gemm g{(const bf16_t*)(P.ws + WS_XB), (const bf16_t*)(P.ws + WS_WOUT) + (size_t)l * DM * DM, MTOK, DM, DM};
    pg8::StaticOrder S; S.init(MTOK, DM, nb, bid);
    pg8::EpiOut E{l == 0 ? (bf16_t*)P.out : (bf16_t*)(P.ws + WS_MIXOUT), (float*)(P.ws + (l == 0 ? WS_SSQ0 : WS_SSQ)), l == 0 ? 4096 : 2048};
    pg8::gemm_phase<pg8::EpiOut, pg8::StaticOrder, true, true>(lds, g, S, E);
}

DI void phase_post(const Params& P, int l, int bid, int nb) {
    const int wid = threadIdx.x >> 6, lane = threadIdx.x & 63;
    const bf16_t* M0 = (const bf16_t*)P.out; const bf16_t* M1 = (const bf16_t*)(P.ws + WS_MIXOUT);
    const float* S0 = (const float*)(P.ws + WS_SSQ0); const float* S1 = (const float*)(P.ws + WS_SSQ);
    bf16_t* XB = (bf16_t*)(P.ws + WS_XB);
    f32x4 w0[8], w1[8];
#pragma unroll
    for (int it = 0; it < 8; ++it) { w0[it] = *(const f32x4*)(P.norm_post + (it * 64 + lane) * 4); w1[it] = l == 1 ? *(const f32x4*)(P.norm_post + DM + (it * 64 + lane) * 4) : w0[it]; }
    for (int row0 = (bid * 8 + wid) * 2; row0 < MTOK; row0 += nb * 16) {
        f32x4 b[2][8]; u32x2 m0[2][8], m1[2][8]; float s0[2], s1[2];
#pragma unroll
        for (int u = 0; u < 2; ++u) { const int row = row0 + u; const float* br = x_row(P, row);
            s0[u] = lane < 32 ? S0[(size_t)row * 32 + lane] : 0.f; s1[u] = (l == 1 && lane < 32) ? S1[(size_t)row * 32 + lane] : 0.f;
#pragma unroll
            for (int it = 0; it < 8; ++it) { const int c = (it * 64 + lane) * 4; b[u][it] = __builtin_nontemporal_load((const f32x4*)(br + c)); m0[u][it] = __builtin_nontemporal_load((const u32x2*)(M0 + (size_t)row * 4096 + c));
                if (l == 1) m1[u][it] = __builtin_nontemporal_load((const u32x2*)(M1 + (size_t)row * DM + c)); } }
        asm volatile("" ::: "memory");
#pragma unroll
        for (int u = 0; u < 2; ++u) { const int row = row0 + u;
            const float r0 = rsqrtf(wave_sum(s0[u]) * (1.0f / DM) + EPS); float ss = 0.f;
#pragma unroll
            for (int it = 0; it < 8; ++it) { const int c = (it * 64 + lane) * 4; const f32x4 w = w0[it]; const f32x4 bb = b[u][it]; const u32x2 m = m0[u][it];
                f32x4 y; y[0] = bb[0] + bflo(m.x) * r0 * w[0]; y[1] = bb[1] + bfhi(m.x) * r0 * w[1]; y[2] = bb[2] + bflo(m.y) * r0 * w[2]; y[3] = bb[3] + bfhi(m.y) * r0 * w[3];
                b[u][it] = y; ss += (y[0] * y[0] + y[1] * y[1]) + (y[2] * y[2] + y[3] * y[3]); }
            if (l == 0) { const float rs = rsqrtf(wave_sum(ss) * (1.0f / DM) + EPS);
#pragma unroll
                for (int it = 0; it < 8; ++it) { const int c = (it * 64 + lane) * 4; const f32x4 y = b[u][it] * rs;
                    u32x2 o; o.x = cvt_pk_bf16(y[0], y[1]); o.y = cvt_pk_bf16(y[2], y[3]); *(u32x2*)(XB + (size_t)row * DM + c) = o; } }
            else { const float r1 = rsqrtf(wave_sum(s1[u]) * (1.0f / DM) + EPS); float* orow = P.out + (size_t)row * DM;
#pragma unroll
                for (int it = 0; it < 8; ++it) { const int c = (it * 64 + lane) * 4; const f32x4 w = w1[it]; const f32x4 y1 = b[u][it]; const u32x2 m = m1[u][it];
                    f32x4 y; y[0] = y1[0] + bflo(m.x) * r1 * w[0]; y[1] = y1[1] + bfhi(m.x) * r1 * w[1]; y[2] = y1[2] + bflo(m.y) * r1 * w[2]; y[3] = y1[3] + bfhi(m.y) * r1 * w[3];
                    __builtin_nontemporal_store(y, (f32x4*)(orow + c)); } } }
    }
}

DI float silu_fast(float z) { return z * __builtin_amdgcn_rcpf(1.0f + __builtin_amdgcn_exp2f(-z * LOG2E)); }
DI void phase_fixup(const Params& P, int l, int bid, int nb) {
    const int wid = threadIdx.x >> 6, lane = threadIdx.x & 63;
    const bf16_t* OF = (const bf16_t*)(P.ws + WS_OFB); const bf16_t* OB = OF + (size_t)MTOK * 1024; const bf16_t* PZ = (const bf16_t*)(P.ws + WS_PZ);
    bf16_t* MI = (bf16_t*)(P.ws + WS_XB); const float* gn = P.gla_norm + l * 256 + (lane & 31) * 8;
    const f32x4 gw0 = *(const f32x4*)gn, gw1 = *(const f32x4*)(gn + 4);
    for (int tok0 = (bid * 8 + wid) * 2; tok0 < MTOK; tok0 += nb * 16) {
        u32x4 a[2][2], b[2][2], z[2][2];
#pragma unroll
        for (int u = 0; u < 2; ++u)
#pragma unroll
            for (int it = 0; it < 2; ++it) { const size_t off = (size_t)(tok0 + u) * 1024 + it * 512 + lane * 8; a[u][it] = __builtin_nontemporal_load((const u32x4*)(OF + off)); b[u][it] = __builtin_nontemporal_load((const u32x4*)(OB + off)); z[u][it] = __builtin_nontemporal_load((const u32x4*)(PZ + off)); }
#pragma unroll
        for (int u = 0; u < 2; ++u)
#pragma unroll
        for (int it = 0; it < 2; ++it) { float o[8];
#pragma unroll
            for (int q = 0; q < 4; ++q) { o[2 * q] = bflo(a[u][it][q]) + bflo(b[u][it][q]); o[2 * q + 1] = bfhi(a[u][it][q]) + bfhi(b[u][it][q]); }
            float ss = 0.f;
#pragma unroll
            for (int q = 0; q < 8; ++q) ss += o[q] * o[q];
#pragma unroll
            for (int m = 16; m >= 1; m >>= 1) ss += __shfl_xor(ss, m);
            const float r = rsqrtf(ss * (1.0f / 256.f) + EPS);
            u32x4 w;
#pragma unroll
            for (int q = 0; q < 4; ++q) { const float g0 = q < 2 ? gw0[2 * q] : gw1[2 * q - 4], g1 = q < 2 ? gw0[2 * q + 1] : gw1[2 * q - 3];
                w[q] = cvt_pk_bf16(o[2 * q] * r * g0 * silu_fast(bflo(z[u][it][q])), o[2 * q + 1] * r * g1 * silu_fast(bfhi(z[u][it][q]))); }
            *(u32x4*)(MI + (size_t)(tok0 + u) * DM + 1024 + it * 512 + lane * 8) = w; }
    }
}

#define KSWZ(row, colB) ((row) * 256 + ((colB) ^ (((row) & 7) << 4)))
#define SBAR() __builtin_amdgcn_sched_barrier(0)
DI int crow(int r, int hi) { return (r & 3) + 8 * (r >> 2) + 4 * hi; }
DI int v_st(int k, int c) { const int kk = (k & ~0xC) | ((k & 4) << 1) | ((k & 8) >> 1); return ((kk >> 3) * 4 + (c >> 5)) * 512 + ((kk & 7) * 32 + (c & 31)) * 2; }
DI int v_rd_base(int lane) { return ((lane & 3) << 3) | (((lane >> 2) & 3) << 6) | (((lane >> 4) & 1) << 5) | (((lane >> 5) & 1) << 8); }
constexpr int v_rd_off(int d0, int ks, int half) { return d0 * 512 + ks * 4096 + half * 2048; }
template <int OFF> DI s16x4 tr_read(int vb) { s16x4 r; asm volatile("ds_read_b64_tr_b16 %0, %1 offset:%2" : "=&v"(r) : "v"(vb), "i"(OFF) : "memory"); return r; }
template <int D0> DI void pv_one(f32x16& od, int vb, bf16x8 pa0, bf16x8 pa1, bf16x8 pa2, bf16x8 pa3) {
    const s16x4 l0 = tr_read<v_rd_off(D0, 0, 0)>(vb), h0 = tr_read<v_rd_off(D0, 0, 1)>(vb), l1 = tr_read<v_rd_off(D0, 1, 0)>(vb), h1 = tr_read<v_rd_off(D0, 1, 1)>(vb);
    const s16x4 l2 = tr_read<v_rd_off(D0, 2, 0)>(vb), h2 = tr_read<v_rd_off(D0, 2, 1)>(vb), l3 = tr_read<v_rd_off(D0, 3, 0)>(vb), h3 = tr_read<v_rd_off(D0, 3, 1)>(vb);
    asm volatile("s_waitcnt lgkmcnt(0)" ::: "memory"); SBAR();
#define PKV(L, H) (bf16x8){L[0], L[1], L[2], L[3], H[0], H[1], H[2], H[3]}
    od = __builtin_amdgcn_mfma_f32_32x32x16_bf16(PKV(l0, h0), pa0, od, 0, 0, 0);
    od = __builtin_amdgcn_mfma_f32_32x32x16_bf16(PKV(l1, h1), pa1, od, 0, 0, 0);
    od = __builtin_amdgcn_mfma_f32_32x32x16_bf16(PKV(l2, h2), pa2, od, 0, 0, 0);
    od = __builtin_amdgcn_mfma_f32_32x32x16_bf16(PKV(l3, h3), pa3, od, 0, 0, 0);
#undef PKV
}
DI void qkt(f32x16& p0, f32x16& p1, const LAS char* Ks, const bf16x8* qr, int r32, int hi) {
    for (int i = 0; i < 16; ++i) { p0[i] = 0.f; p1[i] = 0.f; }
#pragma unroll
    for (int d0 = 0; d0 < 8; ++d0) { const int cb = (d0 * 16 + hi * 8) * 2;
        const bf16x8 b0 = *(const LAS bf16x8*)(Ks + KSWZ(r32, cb));
        const bf16x8 b1 = *(const LAS bf16x8*)(Ks + KSWZ(32 + r32, cb));
        p0 = __builtin_amdgcn_mfma_f32_32x32x16_bf16(b0, qr[d0], p0, 0, 0, 0);
        p1 = __builtin_amdgcn_mfma_f32_32x32x16_bf16(b1, qr[d0], p1, 0, 0, 0); }
}
constexpr int AT_BUF = 65536, AT_TAB = 131072, AT_END = AT_TAB + 8 * 512 * 4;
constexpr int AT_NITEM = NSEQ * 32 * 2 * 2;

DI void phase_attn(const Params& P, int l, LAS unsigned char* lds) {
    const int tid = threadIdx.x, wid = __builtin_amdgcn_readfirstlane(tid >> 6), lane = tid & 63, r32 = lane & 31, hi = lane >> 5;
    const bf16_t* PA = (const bf16_t*)(P.ws + WS_PA); bf16_t* MI = (bf16_t*)(P.ws + WS_XB);
    LAS float* tab = (LAS float*)(lds + AT_TAB);
    __syncthreads();
    { const float* gt = (const float*)(P.ws + WS_TAB);
      for (int i = tid; i < 8 * 512; i += NTHR) { const int h = i >> 9, idx = (i & 511) - 96; tab[i] = (idx >= 0 && idx <= 256) ? gt[h * 257 + idx] : -1e30f; } }
    const int im = wid >> 1, hs = im & 1, isV = im >> 1;
    int soff[8];
#pragma unroll
    for (int q = 0; q < 8; ++q) { const int pp = (wid & 1) * 8 + q, s = pp * 64 + lane;
        if (!isV) { const int row = s >> 4, ch = (s & 15) ^ (row & 7); soff[q] = (hs * 64 + row) * 128 + ch * 8; }
        else { const int o = s * 16, st = o >> 9, wi = o & 511, kk = (st >> 2) * 8 + (wi >> 6), k = (kk & ~0xC) | ((kk & 4) << 1) | ((kk & 8) >> 1), c = (st & 3) * 32 + ((wi & 63) >> 1);
            soff[q] = (hs * 64 + k) * 128 + c; } }
    const int ldsp = im * 16384 + (wid & 1) * 8192;
    const bf16_t* KVB = (const bf16_t*)(P.ws + (isV ? WS_VB : WS_KB));
#define AT_ISSUE(item_, tile_, buf_) do { const int hk_ = ((item_) >> 1) & 1, n_ = ((item_) >> 2) & 31, sq_ = (item_) >> 7; \
        const bf16_t* src_ = KVB + ((size_t)hk_ * MTOK + (size_t)sq_ * SEQL + (n_ - 1 + (tile_)) * 128) * 128; \
        _Pragma("unroll") for (int q_ = 0; q_ < 8; ++q_) __builtin_amdgcn_global_load_lds((const unsigned*)(src_ + soff[q_]), (LAS unsigned*)(lds + (buf_) * AT_BUF + ldsp + q_ * 1024), 16, 0, 0); } while (0)
    const int vbl = (int)(unsigned)(uintptr_t)lds + 32768 + v_rd_base(lane);
    unsigned* qctr = (unsigned*)(P.ws + WS_CTL) + 3584 + 64 * l;
    volatile LAS int* slot = (volatile LAS int*)(lds + AT_END);
    if (tid == 0) { const int a0 = (int)__hip_atomic_fetch_add(qctr, 1u, __ATOMIC_RELAXED, __HIP_MEMORY_SCOPE_AGENT); const int a1 = (int)__hip_atomic_fetch_add(qctr, 1u, __ATOMIC_RELAXED, __HIP_MEMORY_SCOPE_AGENT); slot[0] = a0; slot[1] = a1; }
    __syncthreads();
    int item = slot[0], inext = slot[1]; int pend = AT_NITEM;
    if (item >= AT_NITEM) return;
    int e = 0;
    { const int n0 = (item >> 2) & 31; __syncthreads(); AT_ISSUE(item, n0 == 0 ? 1 : 0, 0); }
    bf16x8 qr[8];
#define AT_QLOAD(item_) do { const int half_ = (item_) & 1, hk_ = ((item_) >> 1) & 1, n_ = ((item_) >> 2) & 31, sq_ = (item_) >> 7; \
        const int g_ = hk_ * 4 + half_ * 2 + (wid >> 2), rq_ = n_ * 128 + ((wid & 3) ^ ((wid >> 2) << 1)) * 32; \
        const bf16_t* qp_ = PA + ((size_t)sq_ * SEQL + rq_ + r32) * 2560 + g_ * 128 + hi * 8; \
        _Pragma("unroll") for (int d0_ = 0; d0_ < 8; ++d0_) qr[d0_] = *(const bf16x8*)(qp_ + d0_ * 16); } while (0)
    AT_QLOAD(item);
    for (; item < AT_NITEM; ) {
        const int half = item & 1, hk = (item >> 1) & 1, n = (item >> 2) & 31, sq = item >> 7;
        const int g = hk * 4 + half * 2 + (wid >> 2), rq = n * 128 + ((wid & 3) ^ ((wid >> 2) << 1)) * 32;
        const size_t tok = (size_t)sq * SEQL + rq + r32;

        float m_run = P.sink[l * 8 + g] * LOG2E, l_run = 1.f;
        f32x16 o[4]; for (int d = 0; d < 4; ++d) for (int i = 0; i < 16; ++i) o[d][i] = 0.f;
        const int t_lo = n == 0 ? 1 : 0, t_hi = n == 31 ? 2 : 3;
        const size_t tokw = (size_t)sq * SEQL + rq;
        const bf16_t* zp = PA + (tokw + (lane >> 4)) * 2560 + 1536 + g * 128 + (lane & 15) * 8; u32x4 zz[8];
        const LAS float* tg = tab + g * 512 + 96 + 128 - r32;
        for (int t = t_lo; t < t_hi; ++t, ++e) {
            asm volatile("s_waitcnt vmcnt(0)" ::: "memory");
            if (t == t_lo + 1 && tid == 0) slot[2] = pend;
            asm volatile("s_waitcnt lgkmcnt(0)" ::: "memory");
            __builtin_amdgcn_s_barrier();
            asm volatile("" ::: "memory");
            if (t == t_lo && tid == 0) pend = (int)__hip_atomic_fetch_add(qctr, 1u, __ATOMIC_RELAXED, __HIP_MEMORY_SCOPE_AGENT);
            {
              if (t + 1 < t_hi) AT_ISSUE(item, t + 1, (e + 1) & 1);
              else if (inext < AT_NITEM) { const int ni = inext; AT_ISSUE(ni, (((ni >> 2) & 31) == 0 ? 1 : 0), (e + 1) & 1); }
              if (t + 1 == t_hi) {
#pragma unroll
                  for (int it = 0; it < 4; ++it) zz[it] = *(const u32x4*)(zp + (size_t)it * 4 * 2560); } }
            const LAS char* Bf = (const LAS char*)lds + (e & 1) * AT_BUF;
#pragma unroll
            for (int h2 = 0; h2 < 2; ++h2) {
                const int kp0 = (n - 1 + t) * 128 + h2 * 64;
                if (kp0 + 63 >= rq - 128 && kp0 <= rq + 159) {
                    f32x16 p0, p1;
                    qkt(p0, p1, Bf + h2 * 16384, qr, r32, hi);
                    const LAS float* tq = tg + (kp0 - rq);
                    float pmax = -1e30f;
#pragma unroll
                    for (int r = 0; r < 16; ++r) { p0[r] += tq[crow(r, hi)]; p1[r] += tq[32 + crow(r, hi)]; pmax = fmaxf(pmax, fmaxf(p0[r], p1[r])); }
                    pmax = fmaxf(pmax, __shfl_xor(pmax, 32));
                    float mn = m_run, alpha = 1.f;
                    if (!__all(pmax - m_run <= 8.f)) { mn = fmaxf(m_run, pmax); alpha = __builtin_amdgcn_exp2f(m_run - mn); m_run = mn; }
                    float ps = 0.f;
#pragma unroll
                    for (int r = 0; r < 16; ++r) { p0[r] = __builtin_amdgcn_exp2f(p0[r] - mn); p1[r] = __builtin_amdgcn_exp2f(p1[r] - mn); ps += p0[r] + p1[r]; }
                    ps += __shfl_xor(ps, 32);
                    l_run = l_run * alpha + ps;
                    bf16x8 pa0, pa1, pa2, pa3;
#define PK4(Pv, BASE, OUT) do { unsigned a0 = cvt_pk_bf16(Pv[BASE + 0], Pv[BASE + 1]), a1 = cvt_pk_bf16(Pv[BASE + 2], Pv[BASE + 3]); \
                    unsigned b0_ = cvt_pk_bf16(Pv[BASE + 4], Pv[BASE + 5]), b1_ = cvt_pk_bf16(Pv[BASE + 6], Pv[BASE + 7]); \
                    auto r0_ = __builtin_amdgcn_permlane32_swap(a0, b0_, false, false); auto r1_ = __builtin_amdgcn_permlane32_swap(a1, b1_, false, false); \
                    u32x4 w_ = {r0_[0], r1_[0], r0_[1], r1_[1]}; OUT = __builtin_bit_cast(bf16x8, w_); } while (0)
                    PK4(p0, 0, pa0); PK4(p0, 8, pa1); PK4(p1, 0, pa2); PK4(p1, 8, pa3);
#undef PK4
                    if (__any(alpha < 1.f)) {
#pragma unroll
                        for (int d = 0; d < 4; ++d)
#pragma unroll
                            for (int r = 0; r < 16; ++r) o[d][r] *= alpha; }
                    const int vb = vbl + (e & 1) * AT_BUF + h2 * 16384;
                    pv_one<0>(o[0], vb, pa0, pa1, pa2, pa3); pv_one<1>(o[1], vb, pa0, pa1, pa2, pa3); pv_one<2>(o[2], vb, pa0, pa1, pa2, pa3); pv_one<3>(o[3], vb, pa0, pa1, pa2, pa3);
                }
            }
        }
        if (inext < AT_NITEM) AT_QLOAD(inext);
        const float rl = __builtin_amdgcn_rcpf(l_run);
#pragma unroll
        for (int it = 4; it < 8; ++it) zz[it] = *(const u32x4*)(zp + (size_t)it * 4 * 2560);
        asm volatile("s_waitcnt lgkmcnt(0)" ::: "memory"); __builtin_amdgcn_s_barrier(); asm volatile("" ::: "memory");
        { LAS unsigned char* stg = lds + ((e & 1) ^ 1) * AT_BUF + wid * 8192; int rsw = r32 & 15, lsw = lane; asm volatile("" : "+v"(rsw), "+v"(lsw));
#pragma unroll
          for (int d0 = 0; d0 < 4; ++d0)
#pragma unroll
              for (int a4 = 0; a4 < 4; ++a4) { u32x2 w; w.x = cvt_pk_bf16(o[d0][a4 * 4 + 0] * rl, o[d0][a4 * 4 + 1] * rl); w.y = cvt_pk_bf16(o[d0][a4 * 4 + 2] * rl, o[d0][a4 * 4 + 3] * rl);
                  *(LAS u32x2*)(stg + r32 * 256 + (((d0 * 4 + a4) ^ rsw) << 4) + hi * 8) = w; }
          asm volatile("s_waitcnt lgkmcnt(0)" ::: "memory");
          bf16_t* op = MI + (tokw + (lane >> 4)) * DM + g * 128 + (lane & 15) * 8;
#pragma unroll
          for (int it = 0; it < 8; ++it) { const int row = it * 4 + (lsw >> 4);
              const u32x4 ov = *(const LAS u32x4*)(stg + row * 256 + (((lsw & 15) ^ (row & 15)) << 4)); const u32x4 z = zz[it]; u32x4 w;
#pragma unroll
              for (int q = 0; q < 4; ++q) w[q] = cvt_pk_bf16(bflo(ov[q]) * silu_fast(bflo(z[q])), bfhi(ov[q]) * silu_fast(bfhi(z[q])));
              *(u32x4*)(op + (size_t)it * 4 * DM) = w; if (it & 1) __builtin_amdgcn_sched_barrier(0); } }
        item = inext; inext = slot[2];
    }
#undef AT_ISSUE
#undef AT_QLOAD
    asm volatile("s_waitcnt vmcnt(0)" ::: "memory");
    __syncthreads();
}


typedef float f32x2 __attribute__((ext_vector_type(2)));
typedef __bf16 bfx2 __attribute__((ext_vector_type(2)));
DI unsigned pkbf(float a, float b) { f32x2 v = {a, b}; bfx2 r = __builtin_convertvector(v, bfx2); return __builtin_bit_cast(unsigned, r); }

constexpr int PP_LR = 0, PP_V = 8192, PP_QD = 8192 + 32768, PP_KD = PP_QD + 32768, PP_W = PP_KD + 32768;
DI float logsigmoid_fast(float z) { return fminf(z, 0.f) - 0.6931471805599453f * __builtin_amdgcn_logf(1.0f + __builtin_amdgcn_exp2f(-fabsf(z) * LOG2E)); }

DI void phase_gla_prep(const Params& P, int l, int bid, int nb, LAS unsigned char* lds) {
    const int tid = threadIdx.x, wid = tid >> 6, lane = tid & 63, dpl = lane & 7, rg = lane >> 3, r32 = lane & 31, hi = lane >> 5;
    const bf16_t* PG = (const bf16_t*)(P.ws + WS_PG); const float* LR = (const float*)(P.ws + WS_LR);
    const int c0 = wid * 16 + dpl * 2;
    const int p0 = (c0 & ~15) | (c0 & 3) | ((c0 & 4) << 1) | ((c0 & 8) >> 1);
    int hcur = -1;
    f32x4 n_lr; unsigned n_q[8], n_k[8];
#define PP_FETCH(task_) do { const int c_ = (task_) >> 2, h_ = (task_) & 3; const size_t t0_ = (size_t)c_ * 64; \
        n_lr = *(const f32x4*)(LR + t0_ * 32 + tid * 4); \
        _Pragma("unroll") for (int r_ = 0; r_ < 8; ++r_) { const bf16_t* rp_ = PG + (t0_ + rg * 8 + r_) * 2048 + h_ * 128 + c0; n_q[r_] = *(const unsigned*)rp_; n_k[r_] = *(const unsigned*)(rp_ + 512); } } while (0)
    if (bid < 2560) PP_FETCH(bid);
    f32x2 bbs[2] = {{0.f, 0.f}, {0.f, 0.f}};
    for (int task = bid; task < 2560; task += nb) {
        const int c = task >> 2, h = task & 3;
        __syncthreads();
        if (h != hcur) { hcur = h;
            for (int e = tid; e < 2 * 16 * 128; e += NTHR) { const int dir = e >> 11, k = (e >> 7) & 15, cc = e & 127;
                ((LAS float*)(lds + PP_W))[e] = (dir ? P.w_gk_b : P.w_gk_f)[(size_t)l * 16 * 512 + k * 512 + h * 128 + cc]; }
            bbs[0] = *(const f32x2*)(P.b_gk_f + l * 512 + h * 128 + c0); bbs[1] = *(const f32x2*)(P.b_gk_b + l * 512 + h * 128 + c0); }
        *(LAS f32x4*)(lds + PP_LR + tid * 16) = n_lr;
        unsigned qw[8], kw[8];
#pragma unroll
        for (int r = 0; r < 8; ++r) { qw[r] = n_q[r]; kw[r] = n_k[r]; }
        asm volatile("" : "+v"(qw[0]), "+v"(qw[1]), "+v"(qw[2]), "+v"(qw[3]), "+v"(qw[4]), "+v"(qw[5]), "+v"(qw[6]), "+v"(qw[7]), "+v"(kw[0]), "+v"(kw[1]), "+v"(kw[2]), "+v"(kw[3]), "+v"(kw[4]), "+v"(kw[5]), "+v"(kw[6]), "+v"(kw[7]) :: "memory");
        __builtin_amdgcn_sched_barrier(0);
        { const int wu = __builtin_amdgcn_readfirstlane(wid);
#pragma unroll
          for (int q = 0; q < 4; ++q) { const int row = wu * 8 + q * 2 + (lane >> 5);
              __builtin_amdgcn_global_load_lds((const unsigned*)(PG + ((size_t)c * 64 + row) * 2048 + 1024 + h * 256 + (lane & 31) * 8), (LAS unsigned*)(lds + PP_V + (wu * 8 + q * 2) * 512), 16, 0, 0); } }
        if (task + nb < 2560) PP_FETCH(task + nb);
        asm volatile("s_waitcnt lgkmcnt(0)" ::: "memory"); __builtin_amdgcn_s_barrier(); asm volatile("" ::: "memory");
#pragma unroll 1
        for (int dir = 0; dir < 2; ++dir) {
            float w0[16], w1[16];
#pragma unroll
            for (int k = 0; k < 16; ++k) { const f32x2 t = *(const LAS f32x2*)(lds + PP_W + ((dir * 16 + k) * 128 + c0) * 4); w0[k] = t.x; w1[k] = t.y; }
            const f32x2 bb = dir ? bbs[1] : bbs[0];
            float g0[8], g1[8];
#pragma unroll
            for (int r = 0; r < 8; ++r) { float z0 = bb.x, z1 = bb.y; const LAS float* lr = (const LAS float*)(lds + PP_LR) + (rg * 8 + r) * 32 + dir * 16;
#pragma unroll
                for (int k4 = 0; k4 < 4; ++k4) { const f32x4 t = *(const LAS f32x4*)(lr + k4 * 4);
#pragma unroll
                    for (int u = 0; u < 4; ++u) { z0 += t[u] * w0[k4 * 4 + u]; z1 += t[u] * w1[k4 * 4 + u]; } }
                g0[r] = logsigmoid_fast(z0) * 0.0625f; g1[r] = logsigmoid_fast(z1) * 0.0625f; __builtin_amdgcn_sched_barrier(0); }
            float tot0, tot1;
            if (dir == 0) {
#pragma unroll
                for (int r = 1; r < 8; ++r) { g0[r] += g0[r - 1]; g1[r] += g1[r - 1]; }
                float s0 = g0[7], s1 = g1[7];
#pragma unroll
                for (int o = 8; o < 64; o <<= 1) { const float t0 = __shfl_up(s0, o), t1 = __shfl_up(s1, o); if (lane >= o) { s0 += t0; s1 += t1; } }
                const float e0 = s0 - g0[7], e1 = s1 - g1[7];
#pragma unroll
                for (int r = 0; r < 8; ++r) { g0[r] += e0; g1[r] += e1; }
                tot0 = __shfl(s0, 56 + dpl); tot1 = __shfl(s1, 56 + dpl);
            } else {
#pragma unroll
                for (int r = 6; r >= 0; --r) { g0[r] += g0[r + 1]; g1[r] += g1[r + 1]; }
                float s0 = g0[0], s1 = g1[0];
#pragma unroll
                for (int o = 8; o < 64; o <<= 1) { const float t0 = __shfl_down(s0, o), t1 = __shfl_down(s1, o); if (lane + o < 64) { s0 += t0; s1 += t1; } }
                const float e0 = s0 - g0[0], e1 = s1 - g1[0];
#pragma unroll
                for (int r = 0; r < 8; ++r) { g0[r] += e0; g1[r] += e1; }
                tot0 = __shfl(s0, dpl); tot1 = __shfl(s1, dpl);
            }
            const float d0 = __expf(tot0), d1 = __expf(tot1);
            unsigned kt0[4], kt1[4];
#pragma unroll
            for (int r = 0; r < 8; r += 2) {
                float qa[2][2], ka[2][2], ta[2][2];
#pragma unroll
                for (int u = 0; u < 2; ++u) { const float eb0 = __expf(g0[r + u]), eb1 = __expf(g1[r + u]); const float ib0 = __builtin_amdgcn_rcpf(eb0), ib1 = __builtin_amdgcn_rcpf(eb1);
                    const float q0 = bflo(qw[r + u]), q1 = bfhi(qw[r + u]), k0 = bflo(kw[r + u]), k1 = bfhi(kw[r + u]);
                    qa[u][0] = q0 * eb0; qa[u][1] = q1 * eb1; ka[u][0] = k0 * ib0; ka[u][1] = k1 * ib1; ta[u][0] = k0 * ib0 * d0; ta[u][1] = k1 * ib1 * d1;
                    const int row = rg * 8 + r + u; const int off = row * 256 + ((((p0 >> 3) ^ (row & 15)) << 4) | ((p0 & 7) << 1));
                    *(LAS unsigned*)(lds + PP_QD + dir * 16384 + off) = pkbf(qa[u][0], qa[u][1]);
                    *(LAS unsigned*)(lds + PP_KD + dir * 16384 + off) = pkbf(ka[u][0], ka[u][1]); }
                kt0[r >> 1] = pkbf(ta[0][0], ta[1][0]); kt1[r >> 1] = pkbf(ta[0][1], ta[1][1]);
            }
            unsigned char* pd = P.ws + GL_PD + ((size_t)dir * 2560 + task) * GL_PD_BYTES;
            { const int dA = c0, dB = c0 + 1;
              *(u32x4*)(pd + 24576 + dA * 128 + ((rg ^ ((dA >> 1) & 7)) << 4)) = (u32x4){kt0[0], kt0[1], kt0[2], kt0[3]};
              *(u32x4*)(pd + 24576 + dB * 128 + ((rg ^ ((dB >> 1) & 7)) << 4)) = (u32x4){kt1[0], kt1[1], kt1[2], kt1[3]}; }
            if (rg == 0) { float* dec = (float*)(P.ws + GL_DEC) + ((size_t)dir * 2560 + task) * 128; *(f32x2*)(dec + c0) = (f32x2){d0, d1}; }
        }
        __syncthreads();
        { const int dir = wid >> 2, ti = (wid >> 1) & 1, tj = wid & 1; const int i = ti * 32 + r32, jr = tj * 32 + r32;
          f32x16 acc; for (int x = 0; x < 16; ++x) acc[x] = 0.f;
#pragma unroll
          for (int s = 0; s < 8; ++s) { const int ch = 2 * s + hi;
              const bf16x8 a = *(const LAS bf16x8*)(lds + PP_KD + dir * 16384 + jr * 256 + ((ch ^ (jr & 15)) << 4));
              const bf16x8 b = *(const LAS bf16x8*)(lds + PP_QD + dir * 16384 + i * 256 + ((ch ^ (i & 15)) << 4));
              acc = __builtin_amdgcn_mfma_f32_32x32x16_bf16(a, b, acc, 0, 0, 0); }
          unsigned char* am = P.ws + GL_PD + ((size_t)dir * 2560 + task) * GL_PD_BYTES + 16384;
#pragma unroll
          for (int a4 = 0; a4 < 4; ++a4) { float v[4];
#pragma unroll
              for (int b4 = 0; b4 < 4; ++b4) { const int j = tj * 32 + 8 * a4 + 4 * hi + b4; const bool keep = dir ? (j >= i) : (j <= i); v[b4] = keep ? acc[a4 * 4 + b4] : 0.f; }
              u32x2 w; w.x = pkbf(v[0], v[1]); w.y = pkbf(v[2], v[3]);
              *(u32x2*)(am + i * 128 + ((((4 * tj + a4) ^ ((i >> 1) & 7)) << 4) | (hi << 3))) = w; } }
#pragma unroll
        for (int q = 0; q < 4; ++q) { const int e = q * 512 + tid, dir = e >> 10, o = (e & 1023) * 16;
            *(u32x4*)(P.ws + GL_PD + ((size_t)dir * 2560 + task) * GL_PD_BYTES + o) = *(const LAS u32x4*)(lds + PP_QD + dir * 16384 + o); }
#pragma unroll
        for (int q = 0; q < 4; ++q) { const int e = q * 512 + tid, v = e & 255, jo = e >> 8; unsigned short t[8];
#pragma unroll
            for (int x = 0; x < 8; ++x) t[x] = *(const LAS unsigned short*)(lds + PP_V + (jo * 8 + x) * 512 + v * 2);
            u32x4 w; w.x = t[0] | ((unsigned)t[1] << 16); w.y = t[2] | ((unsigned)t[3] << 16); w.z = t[4] | ((unsigned)t[5] << 16); w.w = t[6] | ((unsigned)t[7] << 16);
            *(u32x4*)(P.ws + GL_VT + (size_t)task * 32768 + v * 128 + ((jo ^ ((v >> 1) & 7)) << 4)) = w; }
    }
}

constexpr int CH_BUF = 74752, CH_QD = 0, CH_AM = 16384, CH_KT = 24576, CH_VT = 40960, CH_DEC = 73728;
DI void phase_gla_chain(const Params& P, int l, int task0, int ntask_stride, LAS unsigned char* lds) {
    const int tid = threadIdx.x, wid = __builtin_amdgcn_readfirstlane(tid >> 6), lane = tid & 63, r32 = lane & 31, hi = lane >> 5;
    bf16_t* OFB = (bf16_t*)(P.ws + WS_OFB);
    for (int task = task0; task < NSEQ * 4 * 2; task += ntask_stride) {
        const int dir = task & 1, h = (task >> 1) & 3, sq = task >> 3;
        f32x16 T[4]; for (int d = 0; d < 4; ++d) for (int x = 0; x < 16; ++x) T[d][x] = 0.f;
#define CH_ISSUE(n_, b_) do { const int cs_ = dir ? 63 - (n_) : (n_); const int ct_ = (sq * 64 + cs_) * 4 + h; \
        const unsigned char* pd_ = P.ws + GL_PD + ((size_t)dir * 2560 + ct_) * GL_PD_BYTES; const unsigned char* vt_ = P.ws + GL_VT + (size_t)ct_ * 32768; \
        _Pragma("unroll") for (int q_ = 0; q_ < 9; ++q_) { const int pc_ = wid * 9 + q_; const unsigned char* src_ = (pc_ < 40 ? pd_ + pc_ * 1024 : vt_ + (pc_ - 40) * 1024) + lane * 16; \
            __builtin_amdgcn_global_load_lds((const unsigned*)src_, (LAS unsigned*)(lds + (b_) * CH_BUF + pc_ * 1024), 16, 0, 2); } \
        if (wid < 2) { const float* dc_ = (const float*)(P.ws + GL_DEC) + ((size_t)dir * 2560 + ct_) * 128 + wid * 64 + lane; \
            __builtin_amdgcn_global_load_lds((const unsigned*)dc_, (LAS unsigned*)(lds + (b_) * CH_BUF + CH_DEC + wid * 256), 4, 0, 0); } } while (0)
        __syncthreads();
        CH_ISSUE(0, 0);
        for (int n = 0; n < 64; ++n) {
            const int b = n & 1;
            if (n == 0) asm volatile("s_waitcnt vmcnt(0)" ::: "memory"); else asm volatile("s_waitcnt vmcnt(16)" ::: "memory");
            __builtin_amdgcn_s_barrier();
            asm volatile("" ::: "memory");
            if (n + 1 < 64) CH_ISSUE(n + 1, b ^ 1);
            const LAS unsigned char* B = lds + b * CH_BUF;
            const int i0 = r32, i1 = 32 + r32; const int vv = wid * 32 + r32;
            bf16x8 fa[8], fb[8], vf[4];
            f32x16 o[2]; for (int x = 0; x < 16; ++x) { o[0][x] = 0.f; o[1][x] = 0.f; }
#define RD_QD(dst, s0) _Pragma("unroll") for (int s_ = 0; s_ < 4; ++s_) { dst[s_] = *(const LAS bf16x8*)(B + CH_QD + i0 * 256 + (((2 * ((s0) + s_) + hi) ^ (i0 & 15)) << 4)); \
                dst[4 + s_] = *(const LAS bf16x8*)(B + CH_QD + i1 * 256 + (((2 * ((s0) + s_) + hi) ^ (i1 & 15)) << 4)); }
#define RD_KT(dst, db0) _Pragma("unroll") for (int q_ = 0; q_ < 2; ++q_) { const int d_ = ((db0) + q_) * 32 + r32; \
                _Pragma("unroll") for (int ks_ = 0; ks_ < 4; ++ks_) dst[q_ * 4 + ks_] = *(const LAS bf16x8*)(B + CH_KT + d_ * 128 + (((2 * ks_ + hi) ^ ((d_ >> 1) & 7)) << 4)); }
#define DECAY(db_) do { f32x4 dc_[4]; _Pragma("unroll") for (int a4_ = 0; a4_ < 4; ++a4_) dc_[a4_] = *(const LAS f32x4*)(B + CH_DEC + ((db_) * 32 + 8 * a4_ + 4 * hi) * 4); \
                _Pragma("unroll") for (int a4_ = 0; a4_ < 4; ++a4_) _Pragma("unroll") for (int b4_ = 0; b4_ < 4; ++b4_) T[db_][a4_ * 4 + b4_] *= dc_[a4_][b4_]; } while (0)
#define MM_QD(src, s0) _Pragma("unroll") for (int s_ = 0; s_ < 4; ++s_) { const int db_ = ((s0) + s_) >> 1, o8_ = (((s0) + s_) & 1) * 8; \
                u32x4 w_ = {pkbf(T[db_][o8_ + 0], T[db_][o8_ + 1]), pkbf(T[db_][o8_ + 2], T[db_][o8_ + 3]), pkbf(T[db_][o8_ + 4], T[db_][o8_ + 5]), pkbf(T[db_][o8_ + 6], T[db_][o8_ + 7])}; \
                const bf16x8 sf_ = __builtin_bit_cast(bf16x8, w_); \
                o[0] = __builtin_amdgcn_mfma_f32_32x32x16_bf16(src[s_], sf_, o[0], 0, 0, 0); o[1] = __builtin_amdgcn_mfma_f32_32x32x16_bf16(src[4 + s_], sf_, o[1], 0, 0, 0); }
#define MM_KT(src, db0) _Pragma("unroll") for (int q_ = 0; q_ < 2; ++q_) { \
                _Pragma("unroll") for (int ks_ = 0; ks_ < 4; ++ks_) T[(db0) + q_] = __builtin_amdgcn_mfma_f32_32x32x16_bf16(src[q_ * 4 + ks_], vf[ks_], T[(db0) + q_], 0, 0, 0); }
            RD_QD(fa, 0);
#pragma unroll
            for (int ks = 0; ks < 4; ++ks) vf[ks] = *(const LAS bf16x8*)(B + CH_VT + vv * 128 + (((2 * ks + hi) ^ ((vv >> 1) & 7)) << 4));
            __builtin_amdgcn_sched_barrier(0);
            RD_QD(fb, 4);
            __builtin_amdgcn_sched_barrier(0);
            MM_QD(fa, 0);
            DECAY(0); DECAY(1);
            __builtin_amdgcn_sched_barrier(0);
#pragma unroll
            for (int ks = 0; ks < 4; ++ks) { fa[ks] = *(const LAS bf16x8*)(B + CH_AM + i0 * 128 + (((2 * ks + hi) ^ ((i0 >> 1) & 7)) << 4)); fa[4 + ks] = *(const LAS bf16x8*)(B + CH_AM + i1 * 128 + (((2 * ks + hi) ^ ((i1 >> 1) & 7)) << 4)); }
            __builtin_amdgcn_sched_barrier(0);
            MM_QD(fb, 4);
            DECAY(2); DECAY(3);
            __builtin_amdgcn_sched_barrier(0);
            RD_KT(fb, 0);
            __builtin_amdgcn_sched_barrier(0);
#pragma unroll
            for (int ks = 0; ks < 4; ++ks) { o[0] = __builtin_amdgcn_mfma_f32_32x32x16_bf16(fa[ks], vf[ks], o[0], 0, 0, 0); o[1] = __builtin_amdgcn_mfma_f32_32x32x16_bf16(fa[4 + ks], vf[ks], o[1], 0, 0, 0); }
            __builtin_amdgcn_sched_barrier(0);
            RD_KT(fa, 2);
            __builtin_amdgcn_sched_barrier(0);
            MM_KT(fb, 0);
            __builtin_amdgcn_sched_barrier(0);
            MM_KT(fa, 2);
#undef RD_QD
#undef RD_KT
#undef MM_QD
#undef MM_KT
#undef DECAY
            { const int cs = dir ? 63 - n : n; const size_t tokb = (size_t)sq * SEQL + cs * 64; const int odd = lane & 1;
              bf16_t* ob = OFB + (size_t)dir * MTOK * 1024 + h * 256 + wid * 32 + (r32 & ~1);
#pragma unroll
              for (int ib = 0; ib < 2; ++ib)
#pragma unroll
                  for (int x = 0; x < 16; x += 2) { float ea_ = o[ib][x], eb_ = o[ib][x + 1]; asm volatile("" : "+v"(ea_), "+v"(eb_)); const float mine = odd ? eb_ : ea_, give = odd ? ea_ : eb_;
                      const float got = __int_as_float(__builtin_amdgcn_update_dpp(0, __float_as_int(give), 0xB1, 0xF, 0xF, true));
                      const unsigned w = odd ? pkbf(got, mine) : pkbf(mine, got);
                      *(unsigned*)(ob + (tokb + ib * 32 + crow(x + odd, hi)) * 1024) = w; } }
        }
#undef CH_ISSUE
    }
}


#define XB_TMO      128
#define XB_XCNT(j)  (256  + 64 * (j))
#define XB_XSUB(j)  (1280 + 64 * (j))
#define XB_XGEN(j)  (2304 + 64 * (j))
#define XB_TOP      3328
#define XB_TOPGEN   3392
#define XCD_BAR_WORDS 3456
#define XB_SPIN_CAP (1u << 18)

__device__ __forceinline__ unsigned xb_ld(unsigned* p)              { return __hip_atomic_load(p, __ATOMIC_RELAXED, __HIP_MEMORY_SCOPE_AGENT); }
__device__ __forceinline__ unsigned xb_add(unsigned* p, unsigned v) { return __hip_atomic_fetch_add(p, v, __ATOMIC_RELAXED, __HIP_MEMORY_SCOPE_AGENT); }
__device__ __forceinline__ unsigned xb_xcc_id() { return (unsigned)__builtin_amdgcn_s_getreg((3 << 11) | 20) & 0xFu; }
#define XB_SPIN(cond, bar) do { unsigned _sp = 0; while (cond) { __builtin_amdgcn_s_sleep(1); \
    if ((++_sp & 255u) == 0u) { if (xb_ld(&(bar)[XB_TMO])) break; if (_sp > XB_SPIN_CAP) { atomicAdd(&(bar)[XB_TMO], 1u); break; } } } } while (0)

struct XcdBarrier {
    unsigned* bar; unsigned x;
    volatile LAS unsigned* st;
};

__device__ __forceinline__ XcdBarrier xcd_barrier_post(unsigned* bar, volatile LAS unsigned* st) {
    XcdBarrier b; b.bar = bar; b.x = xb_xcc_id(); b.st = st;
    if (threadIdx.x == 0) (void)xb_add(&bar[XB_XCNT(b.x)], 1u);
    return b;
}
__device__ __forceinline__ void xcd_barrier_complete(unsigned* bar, unsigned x, unsigned& nloc, unsigned& nx) {
    const unsigned G = gridDim.x * gridDim.y * gridDim.z;
    unsigned sum, cnt, mine, sp = 0u;
    for (;;) {
        sum = 0u; cnt = 0u; mine = 0u;
#pragma unroll
        for (unsigned j = 0; j < 16; ++j) { const unsigned c = xb_ld(&bar[XB_XCNT(j)]); sum += c; cnt += (c > 0u) ? 1u : 0u; mine = (j == x) ? c : mine; }
        if (sum == G) break;
        __builtin_amdgcn_s_sleep(1);
        if ((++sp & 255u) == 0u) { if (xb_ld(&bar[XB_TMO])) break; if (sp > XB_SPIN_CAP) { atomicAdd(&bar[XB_TMO], 1u); break; } }
    }
    nloc = mine > 0u ? mine : 1u; nx = cnt > 0u ? cnt : 1u;
}

__device__ __forceinline__ void xcd_barrier(const XcdBarrier& b) {
    asm volatile("s_waitcnt vmcnt(0)" ::: "memory");
    __syncthreads();
    if (threadIdx.x == 0) {
        unsigned* bar = b.bar;
        __builtin_amdgcn_s_waitcnt(0);
        unsigned nloc = b.st[0], nx = b.st[1];
        if (nloc == 0u) { xcd_barrier_complete(bar, b.x, nloc, nx); b.st[0] = nloc; b.st[1] = nx; }
        const unsigned old = xb_add(&bar[XB_XSUB(b.x)], 1u);
        const unsigned gen = old / nloc;
        if (old + 1u == (gen + 1u) * nloc) {
            __builtin_amdgcn_fence(__ATOMIC_RELEASE, "agent");
            asm volatile("s_waitcnt vmcnt(0)" ::: "memory");
            const unsigned og = xb_add(&bar[XB_TOP], 1u);
            const unsigned tg = og / nx;
            if (og + 1u == (tg + 1u) * nx) xb_add(&bar[XB_TOPGEN], 1u);
            else XB_SPIN(xb_ld(&bar[XB_TOPGEN]) == tg, bar);
            __builtin_amdgcn_fence(__ATOMIC_ACQUIRE, "agent");
            xb_add(&bar[XB_XGEN(b.x)], 1u);
            asm volatile("s_waitcnt vmcnt(0)" ::: "memory");
        } else {
            XB_SPIN(xb_ld(&bar[XB_XGEN(b.x)]) == gen, bar);
            __builtin_amdgcn_fence(__ATOMIC_ACQUIRE, "agent");
            asm volatile("s_waitcnt vmcnt(0)" ::: "memory");
        }
    }
    __syncthreads();
}


constexpr int N_PHASES = 13;
#ifndef REP_GEMM
#define REP_GEMM 1
#endif
#ifndef REP_MEM
#define REP_MEM 1
#endif
#ifndef REP_P2
#define REP_P2 1
#endif
__global__ void __launch_bounds__(NTHR, 2) hymba_fwd(Params P) {
    extern __shared__ __attribute__((aligned(16))) unsigned char lds_raw[];
    LAS unsigned char* lds = (LAS unsigned char*)lds_raw;
    const int bid = blockIdx.x, nb = gridDim.x;
    const int lo = P.ph_lo, hi = P.ph_hi;
    XcdBarrier xb; xb.bar = (unsigned*)(P.ws + WS_CTL); xb.x = 0; xb.st = (volatile LAS unsigned*)(lds + LDS_BARW);
#if MK_ONE_LAUNCH
#define SEAM(k) do { if ((k) + 1 < hi) { if ((k) == 0) { cg::this_grid().sync(); if (threadIdx.x < 4) ((volatile LAS unsigned*)(lds + LDS_BARW))[threadIdx.x] = 0u; __syncthreads(); \
        xb = xcd_barrier_post((unsigned*)(P.ws + WS_CTL), (volatile LAS unsigned*)(lds + LDS_BARW)); } else xcd_barrier(xb); } } while (0)
#else
#define SEAM(k) do { } while (0)
#endif
#define IN(k) (lo <= (k) && (k) < hi)
    if (IN(0)) { phase_prep(P, bid, nb, lds); SEAM(0); }
#define LAYER(l, b0) \
    if (IN(b0 + 0)) { _Pragma("unroll 1") for (int rep = 0; rep < REP_GEMM; ++rep) { phase_gates(P, l, bid, nb, lds); phase_inproj(P, l, bid, nb, lds); } SEAM(b0 + 0); } \
    if (IN(b0 + 1)) { _Pragma("unroll 1") for (int rep = 0; rep < REP_MEM; ++rep) phase_gla_prep(P, l, bid, nb, lds); SEAM(b0 + 1); } \
    if (IN(b0 + 2)) { _Pragma("unroll 1") for (int rep = 0; rep < REP_P2; ++rep) { if (bid < 80) phase_gla_chain(P, l, bid, 80, lds); phase_attn(P, l, lds); } SEAM(b0 + 2); } \
    if (IN(b0 + 3)) { _Pragma("unroll 1") for (int rep = 0; rep < REP_MEM; ++rep) phase_fixup(P, l, bid, nb); SEAM(b0 + 3); } \
    if (IN(b0 + 4)) { _Pragma("unroll 1") for (int rep = 0; rep < REP_GEMM; ++rep) phase_outproj(P, l, bid, nb, lds); SEAM(b0 + 4); } \
    if (IN(b0 + 5)) { phase_post(P, l, bid, nb); SEAM(b0 + 5); }
    LAYER(0, 1)
    LAYER(1, 7)
#undef LAYER
#undef IN
#undef SEAM
}

extern "C" void kernel_launch(void* const* d_in, const int* in_sizes, int n_in, void* d_out, int out_size, void* d_ws, size_t ws_size, hipStream_t stream) {
    static int grid = 0;
    if (grid == 0) {
        if (n_in != 13 || out_size != MTOK * DM || ws_size < WS_END) { fprintf(stderr, "kernel_launch: unexpected shapes (n_in %d out %d ws %zu need %zu)\n", n_in, out_size, ws_size, (size_t)WS_END); grid = -1; return; }
        int dev = 0, cus = 0, per_cu = 0;
        hipGetDevice(&dev); hipDeviceGetAttribute(&cus, hipDeviceAttributeMultiprocessorCount, dev);
        if (hipFuncSetAttribute((const void*)hymba_fwd, hipFuncAttributeMaxDynamicSharedMemorySize, LDS_BYTES) != hipSuccess) { fprintf(stderr, "kernel_launch: hipFuncSetAttribute failed\n"); grid = -1; return; }
        if (hipOccupancyMaxActiveBlocksPerMultiprocessor(&per_cu, (const void*)hymba_fwd, NTHR, LDS_BYTES) != hipSuccess || per_cu < 1) { fprintf(stderr, "kernel_launch: occupancy query gave %d\n", per_cu); per_cu = 1; }
        (void)hipGetLastError();
        grid = cus * 1;
        fprintf(stderr, "kernel_launch: cus %d per_cu %d grid %d\n", cus, per_cu, grid);
    }
    if (grid < 0) return;
    Params p{};
    p.x_prompt = (const float*)d_in[0]; p.x_sample = (const float*)d_in[1]; p.rel_bias = (const float*)d_in[2]; p.w_in = (const float*)d_in[3];
    p.w_gk_f = (const float*)d_in[4]; p.b_gk_f = (const float*)d_in[5]; p.w_gk_b = (const float*)d_in[6]; p.b_gk_b = (const float*)d_in[7];
    p.sink = (const float*)d_in[8]; p.gla_norm = (const float*)d_in[9]; p.w_out = (const float*)d_in[10]; p.norm_pre = (const float*)d_in[11]; p.norm_post = (const float*)d_in[12];
    p.out = (float*)d_out; p.ws = (unsigned char*)d_ws;
#if MK_ONE_LAUNCH
    p.ph_lo = 0; p.ph_hi = N_PHASES;
    void* args[] = {&p};
    hipError_t e = hipLaunchCooperativeKernel((const void*)hymba_fwd, dim3(grid), dim3(NTHR), args, LDS_BYTES, stream);
    if (e != hipSuccess) fprintf(stderr, "kernel_launch: cooperative launch failed: %s (grid %d)\n", hipGetErrorString(e), grid);
#else
    for (int ph = 0; ph < N_PHASES; ++ph) { p.ph_lo = ph; p.ph_hi = ph + 1; hipLaunchKernelGGL(hymba_fwd, dim3(grid), dim3(NTHR), LDS_BYTES, stream, p); }
#endif
}
```
